# Optimizing an MI355X kernel written in HIP

```python
import jax, jax.numpy as jnp
from jax import lax
import numpy as np

D_MODEL = 1024
BATCH = 32
SEQ = 256
DEPTH = 2
DEC_BATCH = 2
DEC_SEQ = 1024
PAST_LEN = 256

GRID_W = 64
N_MIXERS = 2
N_ATTN_LAYERS = (DEPTH + 1) // 2
N_REC_LAYERS = DEPTH // 2
HEAD_DIM = 64
N_Q_HEADS = D_MODEL // HEAD_DIM
N_KV_HEADS = N_Q_HEADS // 4
GQA_GROUP = N_Q_HEADS // N_KV_HEADS
QKV_DIM = (N_Q_HEADS + 2 * N_KV_HEADS) * HEAD_DIM
WINDOW = 128
BLOCK = 128
ROPE_BASE = 10000.0
REC_EXPAND = 128
REC_HEADS = D_MODEL // REC_EXPAND
REC_DK = REC_EXPAND
REC_DV = D_MODEL // REC_HEADS
REC_IN_DIM = 3 * REC_HEADS * REC_DK + 2 * REC_HEADS * REC_DV
CHUNK = 64
D_FF = 2816
MACARON_WEIGHT = 0.5
EPS = 1e-6
MASK_VALUE = -1e30

kernel_name = 'hybrid_diffusion_swa_hgrn2_macaron_step'


def rmsnorm(x, g):
    xf = x.astype(jnp.float32)
    y = xf * lax.rsqrt(jnp.mean(xf * xf, axis=-1, keepdims=True) + EPS)
    return (y * g.astype(jnp.float32)).astype(x.dtype)


def sublayer_in(x, g, mod, slot):
    return rmsnorm(x, g) * (1 + mod[..., slot, 1, :]) + mod[..., slot, 0, :]


def sublayer_out(x, out, g, mod, slot, weight):
    return x + weight * mod[..., slot, 2, :] * rmsnorm(out, g)


def swiglu(h, w_in, w_out):
    a, b = jnp.split(h @ w_in, 2, axis=-1)
    return (jax.nn.silu(a) * b) @ w_out


def ffn_sublayer(x, g_pre, g_post, mod, slot, w_in, w_out):
    h = sublayer_in(x, g_pre, mod, slot)
    return sublayer_out(x, swiglu(h, w_in, w_out), g_post, mod, slot, MACARON_WEIGHT)


def attn_project(h, w_qkv):
    B, L, _ = h.shape
    q, k, v = jnp.split(h @ w_qkv, [N_Q_HEADS * HEAD_DIM, (N_Q_HEADS + N_KV_HEADS) * HEAD_DIM], axis=-1)
    return (q.reshape(B, L, N_KV_HEADS, GQA_GROUP, HEAD_DIM),
            k.reshape(B, L, N_KV_HEADS, HEAD_DIM),
            v.reshape(B, L, N_KV_HEADS, HEAD_DIM))


def axial_rope(x, T):
    rows = T // GRID_W
    row = jnp.repeat(jnp.arange(rows), GRID_W).astype(jnp.float32)
    col = jnp.tile(jnp.arange(GRID_W), rows).astype(jnp.float32)
    nf = HEAD_DIM // 4
    inv = ROPE_BASE ** (-jnp.arange(nf, dtype=jnp.float32) / nf)
    bshape = (1, T) + (1,) * (x.ndim - 3) + (nf,)

    def rot(xh, pos):
        ang = (pos[:, None] * inv[None, :]).reshape(bshape)
        cos = jnp.cos(ang).astype(x.dtype)
        sin = jnp.sin(ang).astype(x.dtype)
        x1, x2 = jnp.split(xh, 2, axis=-1)
        return jnp.concatenate([x1 * cos - x2 * sin, x1 * sin + x2 * cos], axis=-1)

    half = HEAD_DIM // 2
    return jnp.concatenate([rot(x[..., :half], row), rot(x[..., half:], col)], axis=-1)


def softmax_with_sink(s, sink):
    sk = sink.astype(jnp.float32).reshape(1, N_KV_HEADS, GQA_GROUP, 1, 1)
    m = jnp.maximum(jnp.max(s, axis=-1, keepdims=True), sk)
    e = jnp.exp(s - m)
    return e / (jnp.sum(e, axis=-1, keepdims=True) + jnp.exp(sk - m))


def ctx_attention(q, k, v, sink):
    B, L = q.shape[:2]
    scale = HEAD_DIM ** -0.5

    def one(b):
        qb = lax.dynamic_slice_in_dim(q, b * BLOCK, BLOCK, axis=1)
        s = jnp.einsum('bqhgd,bkhd->bhgqk', qb, k).astype(jnp.float32) * scale
        p = softmax_with_sink(s, sink).astype(v.dtype)
        return jnp.einsum('bhgqk,bkhd->bqhgd', p, v)

    o = lax.map(one, jnp.arange(L // BLOCK))
    return jnp.moveaxis(o, 0, 1).reshape(B, L, N_Q_HEADS * HEAD_DIM)


def latent_attention(q, k, v, k_ctx, v_ctx, sink):
    B, T = q.shape[:2]
    scale = HEAD_DIM ** -0.5
    pad = ((0, 0), (BLOCK, BLOCK), (0, 0), (0, 0))
    k_pad = jnp.pad(k, pad)
    v_pad = jnp.pad(v, pad)

    def one(b):
        start = b * BLOCK
        qb = lax.dynamic_slice_in_dim(q, start, BLOCK, axis=1)
        kw = lax.dynamic_slice_in_dim(k_pad, start, 3 * BLOCK, axis=1)
        vw = lax.dynamic_slice_in_dim(v_pad, start, 3 * BLOCK, axis=1)
        qi = start + jnp.arange(BLOCK)
        kj = start - BLOCK + jnp.arange(3 * BLOCK)
        valid = (jnp.abs(qi[:, None] - kj[None, :]) <= WINDOW) & (kj >= 0)[None, :] & (kj < T)[None, :]
        s_w = jnp.einsum('bqhgd,bkhd->bhgqk', qb, kw).astype(jnp.float32) * scale
        s_w = jnp.where(valid, s_w, MASK_VALUE)
        s_c = jnp.einsum('bqhgd,bkhd->bhgqk', qb, k_ctx).astype(jnp.float32) * scale
        p = softmax_with_sink(jnp.concatenate([s_w, s_c], axis=-1), sink).astype(v.dtype)
        return (jnp.einsum('bhgqk,bkhd->bqhgd', p[..., :3 * BLOCK], vw)
                + jnp.einsum('bhgqk,bkhd->bqhgd', p[..., 3 * BLOCK:], v_ctx))

    o = lax.map(one, jnp.arange(T // BLOCK))
    return jnp.moveaxis(o, 0, 1).reshape(B, T, N_Q_HEADS * HEAD_DIM)


def hgrn_gates(z, lb):
    zf = z.astype(jnp.float32)
    lbf = lb.reshape(REC_HEADS, REC_DK)
    logf = jnp.log(lbf + (1 - lbf) * jax.nn.sigmoid(zf))
    key = (1 - lbf) * jax.nn.sigmoid(-zf)
    return logf, key


def chunk_recurrence(q, k, v, logf, s0):
    B, T, H, _ = q.shape
    nc = T // CHUNK
    rs = lambda t: t.reshape(B, nc, CHUNK, H, t.shape[-1])
    q, k, v, logf = rs(q), rs(k), rs(v), rs(logf)
    bcum = jnp.cumsum(logf, axis=2)
    blast = bcum[:, :, -1]
    q_dec = q * jnp.exp(bcum)
    k_inv = k * jnp.exp(-bcum)
    causal = jnp.tril(jnp.ones((CHUNK, CHUNK), dtype=bool))
    a = jnp.where(causal, jnp.einsum('bnchk,bnshk->bnhcs', q_dec, k_inv), 0.0)
    o_intra = jnp.einsum('bnhcs,bnshv->bnchv', a, v)
    k_end = k * jnp.exp(blast[:, :, None] - bcum)
    upd = jnp.einsum('bnshk,bnshv->bnhkv', k_end, v)
    dec = jnp.exp(blast)

    def step(s, xs):
        d, u = xs
        return d[..., None] * s + u, s

    s_fin, s_start = lax.scan(step, s0, (jnp.moveaxis(dec, 1, 0), jnp.moveaxis(upd, 1, 0)))
    s_start = jnp.moveaxis(s_start, 0, 1)
    o_inter = jnp.einsum('bnchk,bnhkv->bnchv', q_dec, s_start)
    return (o_intra + o_inter).reshape(B, T, H, v.shape[-1]), s_fin


def hgrn_mixer(h, s0, w_in, lb_f, lb_b, g_norm, w_out):
    B, T, _ = h.shape
    q, i_in, z_f, z_b, g = jnp.split(h @ w_in, [REC_HEADS * REC_DK, REC_HEADS * (REC_DK + REC_DV),
                                              REC_HEADS * (2 * REC_DK + REC_DV), REC_HEADS * (3 * REC_DK + REC_DV)], axis=-1)
    shk = (B, T, REC_HEADS, REC_DK)
    qf = jax.nn.silu(q.reshape(shk).astype(jnp.float32)) * (REC_DK ** -0.5)
    vf = i_in.reshape(B, T, REC_HEADS, REC_DV).astype(jnp.float32)
    logf_f, k_f = hgrn_gates(z_f.reshape(shk), lb_f)
    logf_b, k_b = hgrn_gates(z_b.reshape(shk), lb_b)
    s0f = s0.astype(jnp.float32)
    o_f, s_f = chunk_recurrence(qf, k_f, vf, logf_f, s0f[:, 0])
    flip = lambda t: jnp.flip(t, axis=1)
    o_b, s_b = chunk_recurrence(flip(qf), flip(k_b), flip(vf), flip(logf_b), s0f[:, 1])
    o = rmsnorm(o_f + flip(o_b), g_norm.reshape(REC_HEADS, REC_DV)).reshape(B, T, REC_HEADS * REC_DV)
    o = o.astype(h.dtype) * jax.nn.silu(g)
    return o @ w_out, jnp.stack([s_f, s_b], axis=1)


def setup_inputs(seed: int = 0) -> dict:
    key = jax.random.key(seed)
    ks = jax.random.split(key, 20)
    nrm = lambda k, shape, s: jax.random.normal(k, shape, jnp.float32) * s
    D = D_MODEL
    return {
        'x_prompt': nrm(ks[0], (BATCH, SEQ, D), 1.0),
        'x_sample': nrm(ks[1], (DEC_BATCH, DEC_SEQ, D), 1.0),
        'c': nrm(ks[2], (DEC_BATCH, D), 1.0),
        'cache_k': nrm(ks[3], (DEC_BATCH, N_ATTN_LAYERS, PAST_LEN, N_KV_HEADS, HEAD_DIM), 1.0),
        'cache_v': nrm(ks[4], (DEC_BATCH, N_ATTN_LAYERS, PAST_LEN, N_KV_HEADS, HEAD_DIM), 1.0),
        'state_s': nrm(ks[5], (DEC_BATCH, N_REC_LAYERS, 2, REC_HEADS, REC_DK, REC_DV), 0.5),
        'c_ctx': nrm(ks[6], (D,), 1.0),
        'w_ada': nrm(ks[7], (DEPTH, D, 9 * D), 0.5 * D ** -0.5),
        'b_ada': nrm(ks[8], (DEPTH, 9 * D), 0.01),
        'norm_pre': 1.0 + nrm(ks[9], (DEPTH, 3, D), 0.02),
        'norm_post': 1.0 + nrm(ks[10], (DEPTH, 3, D), 0.02),
        'w_ffn_in': nrm(ks[11], (DEPTH, 2, D, 2 * D_FF), D ** -0.5),
        'w_ffn_out': nrm(ks[12], (DEPTH, 2, D_FF, D), D_FF ** -0.5),
        'w_qkv': nrm(ks[13], (N_ATTN_LAYERS, D, QKV_DIM), D ** -0.5),
        'w_attn_out': nrm(ks[14], (N_ATTN_LAYERS, N_Q_HEADS * HEAD_DIM, D), D ** -0.5),
        'attn_sink': nrm(ks[15], (N_ATTN_LAYERS, N_Q_HEADS), 0.5),
        'w_rec_in': nrm(ks[16], (N_REC_LAYERS, D, REC_IN_DIM), D ** -0.5),
        'rec_lb_logits': nrm(ks[17], (2, DEPTH, REC_HEADS * REC_DK), 0.1),
        'rec_norm': 1.0 + nrm(ks[18], (N_REC_LAYERS, REC_HEADS * REC_DV), 0.02),
        'w_rec_out': nrm(ks[19], (N_REC_LAYERS, REC_HEADS * REC_DV, D), D ** -0.5),
    }


def reference(x_prompt, x_sample, c, cache_k, cache_v, state_s, c_ctx, w_ada, b_ada, norm_pre, norm_post,
              w_ffn_in, w_ffn_out, w_qkv, w_attn_out, attn_sink, w_rec_in, rec_lb_logits, rec_norm, w_rec_out):
    xp, xs = x_prompt, x_sample
    Bp = xp.shape[0]
    Bs, T = xs.shape[:2]
    lb_soft = jax.nn.softmax(rec_lb_logits.astype(jnp.float32), axis=1)
    lb_all = jnp.cumsum(lb_soft, axis=1) - lb_soft[:, :1]
    new_k, new_v, new_s = [], [], []
    for i in range(DEPTH):
        mod_p = (jax.nn.silu(c_ctx) @ w_ada[i] + b_ada[i]).reshape(3, 3, D_MODEL)
        mod_s = (jax.nn.silu(c) @ w_ada[i] + b_ada[i]).reshape(Bs, 1, 3, 3, D_MODEL)
        xp = ffn_sublayer(xp, norm_pre[i, 0], norm_post[i, 0], mod_p, 0, w_ffn_in[i, 0], w_ffn_out[i, 0])
        xs = ffn_sublayer(xs, norm_pre[i, 0], norm_post[i, 0], mod_s, 0, w_ffn_in[i, 0], w_ffn_out[i, 0])
        hp = sublayer_in(xp, norm_pre[i, 1], mod_p, 1)
        hs = sublayer_in(xs, norm_pre[i, 1], mod_s, 1)
        j = i // N_MIXERS
        if i % N_MIXERS == 0:
            qp, kp, vp = attn_project(hp, w_qkv[j])
            op = ctx_attention(qp, kp, vp, attn_sink[j]) @ w_attn_out[j]
            qs, ks_, vs = attn_project(hs, w_qkv[j])
            qs = axial_rope(qs, T)
            ks_ = axial_rope(ks_, T)
            os_ = latent_attention(qs, ks_, vs, cache_k[:, j], cache_v[:, j], attn_sink[j]) @ w_attn_out[j]
            new_k.append(kp)
            new_v.append(vp)
        else:
            s_zero = jnp.zeros((Bp, 2, REC_HEADS, REC_DK, REC_DV), jnp.float32)
            op, sp = hgrn_mixer(hp, s_zero, w_rec_in[j], lb_all[0, i], lb_all[1, i], rec_norm[j], w_rec_out[j])
            os_, _ = hgrn_mixer(hs, state_s[:, j], w_rec_in[j], lb_all[0, i], lb_all[1, i], rec_norm[j], w_rec_out[j])
            new_s.append(sp)
        xp = sublayer_out(xp, op, norm_post[i, 1], mod_p, 1, 1.0)
        xs = sublayer_out(xs, os_, norm_post[i, 1], mod_s, 1, 1.0)
        xp = ffn_sublayer(xp, norm_pre[i, 2], norm_post[i, 2], mod_p, 2, w_ffn_in[i, 1], w_ffn_out[i, 1])
        xs = ffn_sublayer(xs, norm_pre[i, 2], norm_post[i, 2], mod_s, 2, w_ffn_in[i, 1], w_ffn_out[i, 1])
    new_cache_k = jnp.stack(new_k, axis=1)
    new_cache_v = jnp.stack(new_v, axis=1)
    new_state_s = jnp.stack(new_s, axis=1)
    return (xp, xs, new_cache_k, new_cache_v, new_state_s)
```

```cpp
#include <hip/hip_runtime.h>
#include <hip/hip_cooperative_groups.h>
#include <cstdio>
#include <cstdint>
namespace cg = cooperative_groups;
namespace pg8 {
#define PG8_LAS __attribute__((address_space(3)))
typedef unsigned short bf16_t;
typedef short bf16x8 __attribute__((ext_vector_type(8)));
typedef float f32x4 __attribute__((ext_vector_type(4)));
typedef unsigned u32x4 __attribute__((ext_vector_type(4)));
constexpr int BM = 256, BK = 64, HALF = 128, HTB = HALF * BK * 2  , STAGE_BYTES = 8 * HTB, NXCD = 8, WGM = 8;

__host__ __device__ __forceinline__ int lds_byte(int r, int c) { const int st = (r >> 4) * 2 + (c >> 5), rr = r & 15, cc = c & 31, ob = rr * 64 + cc * 2; return st * 1024 + (ob ^ (((ob >> 9) & 1) << 5)); }
__host__ __device__ __forceinline__ void stage_rc(int b, int& R, int& C) { const int st = b / 1024, sb = b % 1024, swz = sb ^ (((sb >> 9) & 1) << 5); R = (st >> 1) * 16 + swz / 64; C = (st & 1) * 32 + (swz % 64) / 2; }
__host__ __device__ __forceinline__ int perm32(int rho) { const int n = rho >> 4, i = rho & 15; return 8 * (i >> 2) + 4 * n + (i & 3); }

struct Unit { int pm, pn; };
struct Gemm { const bf16_t* A; const bf16_t* Bt; int M, N, K; };

struct StaticOrder {
    int nM, nN, nwg, G, c;
    __host__ __device__ void init(int M, int N, int G_, int c_) { nM = M / BM; nN = N / BM; nwg = nM * nN; G = G_; c = c_; }
    __host__ __device__ bool next(int i, Unit& u) const {
        const long L = (long)i * G + c; if (L >= nwg) return false;
        int wgid = (int)L; { const int q = nwg / NXCD, r = nwg % NXCD, xcd = wgid % NXCD, off = wgid / NXCD; wgid = (xcd < r ? xcd * (q + 1) : r * (q + 1) + (xcd - r) * q) + off; }
        const int nig = WGM * nN, gid = wgid / nig, fm = gid * WGM, gsz = (nM - fm) < WGM ? (nM - fm) : WGM;
        u.pm = fm + ((wgid % nig) % gsz); u.pn = (wgid % nig) / gsz; return true;
    }
    __device__ __forceinline__ void a_ready(const Unit&) const {}
    __device__ __forceinline__ void done(const Unit&) const {}
};

__device__ __forceinline__ unsigned cvt_pk_bf16(float lo, float hi) { unsigned r; asm volatile("v_cvt_pk_bf16_f32 %0, %1, %2" : "=v"(r) : "v"(lo), "v"(hi)); return r; }
template <class Epi, class Sched, bool ALIGN_EPI = false, bool SP2 = false>
__device__ __forceinline__ void gemm_phase(PG8_LAS unsigned char* lds, const Gemm g, const Sched& S, const Epi& E) {
    int tid_l = threadIdx.x; asm volatile("" : "+v"(tid_l));
    const int tid = tid_l, wid = __builtin_amdgcn_readfirstlane(tid >> 6), lane = tid & 63, wr = wid >> 2, wc = wid & 3, fr = lane & 15, fq = lane >> 4;
    const int K = g.K, nt = K / BK;
    unsigned voffA[2], voffB[2];
#pragma unroll
    for (int i = 0; i < 2; ++i) { int R, C; stage_rc(tid * 16 + i * 8192, R, C); const int Rb = Epi::PERM ? ((R & ~31) + perm32(R & 31)) : R;
        voffA[i] = (unsigned)(R * K + C) * 2u; voffB[i] = (unsigned)(Rb * K + C) * 2u; }
    const size_t kstep = (size_t)(BK * 2);
    const size_t hstep = (size_t)HALF * K * 2;
    const size_t tstep = 2 * hstep;
    const unsigned ldsw = (unsigned)wid * 1024u;
    const int aoff = lds_byte(wr * 64 + fr, fq * 8), boff = lds_byte(wc * 32 + fr, fq * 8);
#define PG8_SA(b, h) (((b) * 2 + (h)) * HTB)
#define PG8_SB(b, h) ((4 + (b) * 2 + (h)) * HTB)
#define PG8_STAGE(bufoff, gbase, voff) do { _Pragma("unroll") for (int _i = 0; _i < 2; ++_i) \
        __builtin_amdgcn_global_load_lds((const unsigned*)((const char*)(gbase) + (voff)[_i]), (PG8_LAS unsigned*)(lds + (bufoff) + ldsw + _i * 8192), 16, 0, 0); } while (0)
#define PG8_LDA(dst, b, h) do { _Pragma("unroll") for (int m = 0; m < 4; ++m) _Pragma("unroll") for (int k = 0; k < 2; ++k) dst[m][k] = *(const PG8_LAS bf16x8*)(lds + PG8_SA(b, h) + aoff + m * 2048 + k * 1024); } while (0)
#define PG8_LDB(dst, b, h) do { _Pragma("unroll") for (int n = 0; n < 2; ++n) _Pragma("unroll") for (int k = 0; k < 2; ++k) dst[n][k] = *(const PG8_LAS bf16x8*)(lds + PG8_SB(b, h) + boff + n * 2048 + k * 1024); } while (0)
#define PG8_MMA(ai, bj, At, Bt) do { __builtin_amdgcn_s_setprio(1); _Pragma("unroll") for (int m = 0; m < 4; ++m) _Pragma("unroll") for (int n = 0; n < 2; ++n) _Pragma("unroll") for (int k = 0; k < 2; ++k) \
        acc[ai][bj][m][n] = __builtin_amdgcn_mfma_f32_16x16x32_bf16(Bt[n][k], At[m][k], acc[ai][bj][m][n], 0, 0, 0); __builtin_amdgcn_s_setprio(0); } while (0)
#define PG8_WAIT_V(n) asm volatile("s_waitcnt vmcnt(" #n ")" ::: "memory")
#define PG8_WAIT_L(n) asm volatile("s_waitcnt lgkmcnt(" #n ")" ::: "memory")
#define PG8_BAR __builtin_amdgcn_s_barrier()
#define PG8_SCHED __builtin_amdgcn_sched_barrier(0)
    Unit cur, nxt; int ui = 0;
    if (!S.next(0, cur)) return;
    f32x4 acc[2][2][4][2];
#pragma unroll
    for (int a = 0; a < 2; ++a)
#pragma unroll
        for (int b = 0; b < 2; ++b)
#pragma unroll
            for (int m = 0; m < 4; ++m)
#pragma unroll
                for (int n = 0; n < 2; ++n) acc[a][b][m][n] = (f32x4){0.f, 0.f, 0.f, 0.f};
    bf16x8 At[4][2], B0[2][2], B1[2][2];
    const char* cA = (const char*)g.A + (size_t)cur.pm * tstep; const char* cB = (const char*)g.Bt + (size_t)cur.pn * tstep;
    S.a_ready(cur);
    if constexpr (SP2) {
        PG8_STAGE(PG8_SB(0, 0), cB, voffB); PG8_STAGE(PG8_SB(0, 1), cB + hstep, voffB); PG8_STAGE(PG8_SA(0, 0), cA, voffA); PG8_STAGE(PG8_SA(0, 1), cA + hstep, voffA);
        if (wr == 1) PG8_BAR;
        PG8_WAIT_V(2); PG8_BAR;
        PG8_STAGE(PG8_SB(1, 0), cB + kstep, voffB); PG8_STAGE(PG8_SA(1, 0), cA + kstep, voffA); PG8_STAGE(PG8_SB(1, 1), cB + hstep + kstep, voffB);
        PG8_WAIT_V(6); PG8_BAR;
    } else {
        PG8_STAGE(PG8_SB(0, 0), cB, voffB); PG8_STAGE(PG8_SA(0, 0), cA, voffA); PG8_STAGE(PG8_SB(0, 1), cB + hstep, voffB); PG8_STAGE(PG8_SA(0, 1), cA + hstep, voffA);
        if (wr == 1) PG8_BAR;
        PG8_WAIT_V(4); PG8_BAR;
        PG8_STAGE(PG8_SB(1, 0), cB + kstep, voffB); PG8_STAGE(PG8_SA(1, 0), cA + kstep, voffA); PG8_STAGE(PG8_SB(1, 1), cB + hstep + kstep, voffB);
        PG8_WAIT_V(6); PG8_BAR;
    }
    for (;;) {
        const bool has_next = S.next(ui + 1, nxt);
        const char* nA = has_next ? (const char*)g.A + (size_t)nxt.pm * tstep : cA; const char* nB = has_next ? (const char*)g.Bt + (size_t)nxt.pn * tstep : cB;
        for (int t = 0; t < nt; t += 2) {
            const bool last = (t == nt - 2);
            const char* a1 = cA + (size_t)(t + 1) * kstep;
            const char* a2 = last ? nA : cA + (size_t)(t + 2) * kstep; const char* b2 = last ? nB : cB + (size_t)(t + 2) * kstep;
            const char* a3 = a2 + kstep; const char* b3 = b2 + kstep;
            if (last && has_next) S.a_ready(nxt);
            if constexpr (SP2) {
            PG8_LDB(B0, 0, 0); PG8_LDB(B1, 0, 1); PG8_SCHED; PG8_LDA(At, 0, 0); PG8_STAGE(PG8_SA(1, 1), a1 + hstep, voffA);
            PG8_WAIT_V(8); PG8_WAIT_L(0); PG8_BAR; PG8_MMA(0, 0, At, B0); PG8_MMA(0, 1, At, B1); PG8_BAR; PG8_SCHED;
            PG8_LDA(At, 0, 1); PG8_STAGE(PG8_SB(0, 0), b2, voffB); PG8_STAGE(PG8_SB(0, 1), b2 + hstep, voffB); PG8_STAGE(PG8_SA(0, 0), a2, voffA);
            PG8_WAIT_V(8); PG8_WAIT_L(0); PG8_BAR; PG8_MMA(1, 0, At, B0); PG8_MMA(1, 1, At, B1); PG8_BAR; PG8_SCHED;
            PG8_LDB(B0, 1, 0); PG8_LDB(B1, 1, 1); PG8_SCHED; PG8_LDA(At, 1, 0); PG8_STAGE(PG8_SA(0, 1), a2 + hstep, voffA);
            PG8_WAIT_V(8); PG8_WAIT_L(0); PG8_BAR; PG8_MMA(0, 0, At, B0); PG8_MMA(0, 1, At, B1); PG8_BAR; PG8_SCHED;
            PG8_LDA(At, 1, 1); PG8_STAGE(PG8_SB(1, 0), b3, voffB); PG8_STAGE(PG8_SB(1, 1), b3 + hstep, voffB); PG8_STAGE(PG8_SA(1, 0), a3, voffA);
            PG8_WAIT_V(8); PG8_WAIT_L(0); PG8_BAR; PG8_MMA(1, 0, At, B0); PG8_MMA(1, 1, At, B1); PG8_BAR; PG8_SCHED;
            } else {
            PG8_LDB(B0, 0, 0); PG8_SCHED; PG8_LDA(At, 0, 0); PG8_STAGE(PG8_SA(1, 1), a1 + hstep, voffA);
            PG8_WAIT_L(8); PG8_BAR; PG8_WAIT_L(0); PG8_MMA(0, 0, At, B0); PG8_BAR; PG8_SCHED;
            PG8_LDB(B1, 0, 1); PG8_STAGE(PG8_SB(0, 0), b2, voffB);
            PG8_BAR; PG8_WAIT_L(0); PG8_MMA(0, 1, At, B1); PG8_BAR;
            PG8_LDA(At, 0, 1); PG8_STAGE(PG8_SA(0, 0), a2, voffA);
            PG8_BAR; PG8_WAIT_L(0); PG8_MMA(1, 0, At, B0); PG8_BAR; PG8_SCHED;
            PG8_STAGE(PG8_SB(0, 1), b2 + hstep, voffB);
            PG8_WAIT_V(6); PG8_BAR; PG8_MMA(1, 1, At, B1); PG8_BAR;
            PG8_LDB(B0, 1, 0); PG8_SCHED; PG8_LDA(At, 1, 0); PG8_STAGE(PG8_SA(0, 1), a2 + hstep, voffA);
            PG8_WAIT_L(8); PG8_BAR; PG8_WAIT_L(0); PG8_MMA(0, 0, At, B0); PG8_BAR; PG8_SCHED;
            PG8_LDB(B1, 1, 1); PG8_STAGE(PG8_SB(1, 0), b3, voffB);
            PG8_BAR; PG8_WAIT_L(0); PG8_MMA(0, 1, At, B1); PG8_BAR;
            PG8_LDA(At, 1, 1); PG8_STAGE(PG8_SA(1, 0), a3, voffA);
            PG8_BAR; PG8_WAIT_L(0); PG8_MMA(1, 0, At, B0); PG8_BAR; PG8_SCHED;
            PG8_STAGE(PG8_SB(1, 1), b3 + hstep, voffB);
            PG8_WAIT_V(6); PG8_BAR; PG8_MMA(1, 1, At, B1); PG8_BAR;
            }
        }
        if constexpr (ALIGN_EPI) { if (wr == 0) PG8_BAR; }
        if constexpr (!Epi::AFTER_DRAIN) { E(acc, cur, wr, wc, fr, fq); S.done(cur); }
        if (!has_next) break;
#pragma unroll
        for (int a = 0; a < 2; ++a)
#pragma unroll
            for (int b = 0; b < 2; ++b)
#pragma unroll
                for (int m = 0; m < 4; ++m)
#pragma unroll
                    for (int n = 0; n < 2; ++n) acc[a][b][m][n] = (f32x4){0.f, 0.f, 0.f, 0.f};
        cur = nxt; cA = nA; cB = nB; ++ui;
        if constexpr (ALIGN_EPI) { if (wr == 1) PG8_BAR; }
    }
    PG8_WAIT_V(0);
    if constexpr (!ALIGN_EPI) { if (wr == 0) PG8_BAR; }
    PG8_BAR;
    if constexpr (Epi::AFTER_DRAIN) { E.fused(acc, cur, wr, wc, fr, fq, lds, wid, lane); S.done(cur); }
#undef PG8_SA
#undef PG8_SB
#undef PG8_STAGE
#undef PG8_LDA
#undef PG8_LDB
#undef PG8_MMA
#undef PG8_WAIT_V
#undef PG8_WAIT_L
#undef PG8_BAR
#undef PG8_SCHED
}
}

#ifndef MK_MULTI
#define MK_MULTI 0
#endif
#define LAS __attribute__((address_space(3)))
typedef unsigned short bf16_t;
typedef short bf16x8 __attribute__((ext_vector_type(8)));
typedef float f32x4 __attribute__((ext_vector_type(4)));
typedef unsigned u32x4 __attribute__((ext_vector_type(4)));
typedef unsigned u32x2 __attribute__((ext_vector_type(2)));
using pg8::cvt_pk_bf16;

constexpr int D = 1024, MP = 8192, MS = 2048, MT = MP + MS, FF = 2816, NFF1 = 2 * FF, NQKV = 1536, NREC = 5120, NADA = 9216;
constexpr float EPS = 1e-6f;
constexpr int LDS_BYTES = 147456;
constexpr int NPHASES = 24;

constexpr size_t MiB = 1u << 20;
constexpr size_t WS_MODP = 1 * MiB;
constexpr size_t WS_MOD = 5 * MiB;
constexpr size_t WS_LB = 6 * MiB;
constexpr size_t WS_W1 = 8 * MiB;
constexpr size_t WS_W2 = 52 * MiB;
constexpr size_t WS_WQKV = 74 * MiB, WS_WAO = 77 * MiB, WS_WRI = 79 * MiB, WS_WRO = 89 * MiB;
constexpr size_t WS_H = 91 * MiB;
constexpr size_t WS_OUTF = 111 * MiB;
constexpr size_t WS_BIG = 151 * MiB;
constexpr size_t WS_ACT = WS_BIG;
constexpr size_t WS_Q = WS_BIG, WS_KB = WS_BIG + 20 * MiB, WS_VB = WS_BIG + 25 * MiB, WS_AO = WS_BIG + 30 * MiB;
constexpr size_t WS_QR = WS_BIG, WS_VR = WS_BIG + 20 * MiB, WS_KF = WS_BIG + 40 * MiB, WS_KBK = WS_BIG + 60 * MiB, WS_GR = WS_BIG + 80 * MiB;
constexpr size_t WS_LFF = WS_BIG + 100 * MiB, WS_LFB = WS_BIG + 140 * MiB;
constexpr size_t WS_END = WS_BIG + 180 * MiB;

__device__ __forceinline__ float bf2f(unsigned u16) { return __builtin_bit_cast(float, u16 << 16); }
__device__ __forceinline__ float wave_sum(float v) {
#pragma unroll
    for (int o = 1; o < 64; o <<= 1) v += __shfl_xor(v, o);
    return v;
}
__device__ __forceinline__ float frcp(float x) { return __builtin_amdgcn_rcpf(x); }
__device__ __forceinline__ float fsigmoid(float x) { return frcp(1.f + __expf(-x)); }
__device__ __forceinline__ bf16x8 mk8(unsigned a, unsigned b, unsigned c, unsigned d) { u32x4 t = {a, b, c, d}; return __builtin_bit_cast(bf16x8, t); }
#define MFMA16(a, b, c) __builtin_amdgcn_mfma_f32_16x16x32_bf16((a), (b), (c), 0, 0, 0)
#define LDSW() asm volatile("s_waitcnt lgkmcnt(0)" ::: "memory")

using pg8::Unit;
struct EpiSwiGLU {
    static constexpr bool PERM = true, AFTER_DRAIN = false;
    bf16_t* O;
    __device__ __forceinline__ void operator()(const f32x4 (&acc)[2][2][4][2], const Unit& u, int wr, int wc, int fr, int fq) const {
        const int row0 = u.pm * 256 + wr * 64 + fr, col0 = u.pn * 128 + wc * 32 + 8 * fq;
#pragma unroll
        for (int ai = 0; ai < 2; ++ai)
#pragma unroll
            for (int m = 0; m < 4; ++m) {
                bf16_t* p = O + (size_t)(row0 + ai * 128 + m * 16) * FF + col0;
                float r[8];
#pragma unroll
                for (int n = 0; n < 2; ++n)
#pragma unroll
                    for (int j = 0; j < 4; ++j) { const float av = acc[ai][0][m][n][j], bv = acc[ai][1][m][n][j]; r[n * 4 + j] = av * bv * fsigmoid(av); }
                u32x4 w; w.x = cvt_pk_bf16(r[0], r[1]); w.y = cvt_pk_bf16(r[2], r[3]); w.z = cvt_pk_bf16(r[4], r[5]); w.w = cvt_pk_bf16(r[6], r[7]);
                *(u32x4*)p = w;
            }
    }
};
struct EpiF32 {
    static constexpr bool PERM = true, AFTER_DRAIN = false;
    float* O;
    __device__ __forceinline__ void operator()(const f32x4 (&acc)[2][2][4][2], const Unit& u, int wr, int wc, int fr, int fq) const {
        const int row0 = u.pm * 256 + wr * 64 + fr, col0 = u.pn * 256 + wc * 32 + 8 * fq;
#pragma unroll
        for (int ai = 0; ai < 2; ++ai)
#pragma unroll
            for (int m = 0; m < 4; ++m)
#pragma unroll
                for (int bj = 0; bj < 2; ++bj) {
                    float* p = O + (size_t)(row0 + ai * 128 + m * 16) * D + col0 + bj * 128;
                    *(f32x4*)p = acc[ai][bj][m][0]; *(f32x4*)(p + 4) = acc[ai][bj][m][1];
                }
    }
};
struct EpiQKV {
    static constexpr bool PERM = false, AFTER_DRAIN = false;
    unsigned char* ws; float* out;
    __device__ __forceinline__ void operator()(const f32x4 (&acc)[2][2][4][2], const Unit& u, int wr, int wc, int fr, int fq) const {
        bf16_t* Q = (bf16_t*)(ws + WS_Q); bf16_t* KB = (bf16_t*)(ws + WS_KB); bf16_t* VB = (bf16_t*)(ws + WS_VB); float* ck_out = out + (size_t)MT * D; float* cv_out = ck_out + (size_t)MP * 256;
        const int row0 = u.pm * 256 + wr * 64 + fr;
        const bool samp = u.pm >= 32, rope = samp && (u.pn <= 4);
        float inv[4];
#pragma unroll
        for (int j = 0; j < 4; ++j) inv[j] = exp2f(-(float)(4 * fq + j) * (13.287712379549449f / 16.f));
#pragma unroll
        for (int ai = 0; ai < 2; ++ai)
#pragma unroll
            for (int m = 0; m < 4; ++m) {
                const int r = row0 + ai * 128 + m * 16;
                float cs[4], sn[4];
                if (rope) {
                    const int t = (r - MP) & 1023; const float pos = (float)((wc & 1) ? (t & 63) : (t >> 6));
#pragma unroll
                    for (int j = 0; j < 4; ++j) { const float ang = pos * inv[j]; cs[j] = __cosf(ang); sn[j] = __sinf(ang); }
                }
#pragma unroll
                for (int bj = 0; bj < 2; ++bj) {
                    f32x4 v0 = acc[ai][bj][m][0], v1 = acc[ai][bj][m][1];
                    if (rope) {
#pragma unroll
                        for (int j = 0; j < 4; ++j) { const float x1 = v0[j], x2 = v1[j]; v0[j] = x1 * cs[j] - x2 * sn[j]; v1[j] = x1 * sn[j] + x2 * cs[j]; }
                    }
                    const int cc = 128 * bj + 32 * wc + 4 * fq;
                    u32x2 w0, w1; w0.x = cvt_pk_bf16(v0[0], v0[1]); w0.y = cvt_pk_bf16(v0[2], v0[3]); w1.x = cvt_pk_bf16(v1[0], v1[1]); w1.y = cvt_pk_bf16(v1[2], v1[3]);
                    if (u.pn < 4) { bf16_t* p = Q + (size_t)r * D + u.pn * 256 + cc; *(u32x2*)p = w0; *(u32x2*)(p + 16) = w1; }
                    else {
                        bf16_t* p = (u.pn == 4 ? KB : VB) + (size_t)r * 256 + cc; *(u32x2*)p = w0; *(u32x2*)(p + 16) = w1;
                        if (!samp) { float* c = (u.pn == 4 ? ck_out : cv_out) + (size_t)r * 256 + cc; *(f32x4*)c = v0; *(f32x4*)(c + 16) = v1; }
                    }
                }
            }
    }
};
struct EpiRecIn {
    static constexpr bool PERM = true, AFTER_DRAIN = false;
    unsigned char* ws;
    __device__ __forceinline__ void operator()(const f32x4 (&acc)[2][2][4][2], const Unit& u, int wr, int wc, int fr, int fq) const {
        bf16_t* QR = (bf16_t*)(ws + WS_QR); bf16_t* VR = (bf16_t*)(ws + WS_VR); bf16_t* KF = (bf16_t*)(ws + WS_KF); bf16_t* KBK = (bf16_t*)(ws + WS_KBK); bf16_t* GR = (bf16_t*)(ws + WS_GR);
        float* LFF = (float*)(ws + WS_LFF); float* LFB = (float*)(ws + WS_LFB); const float* LB = (const float*)(ws + WS_LB);
        const int row0 = u.pm * 256 + wr * 64 + fr, typ = u.pn >> 2, colb = (u.pn & 3) * 256 + wc * 32 + 8 * fq;
#pragma unroll
        for (int ai = 0; ai < 2; ++ai)
#pragma unroll
            for (int m = 0; m < 4; ++m)
#pragma unroll
                for (int bj = 0; bj < 2; ++bj) {
                    const size_t off = (size_t)(row0 + ai * 128 + m * 16) * D + colb + bj * 128;
                    float x[8], r[8];
#pragma unroll
                    for (int e = 0; e < 8; ++e) x[e] = acc[ai][bj][m][e >> 2][e & 3];
                    bf16_t* dst;
                    if (typ == 0) { dst = QR;
#pragma unroll
                        for (int e = 0; e < 8; ++e) r[e] = x[e] * fsigmoid(x[e]) * 0.08838834764831845f;
                    } else if (typ == 1) { dst = VR;
#pragma unroll
                        for (int e = 0; e < 8; ++e) r[e] = x[e];
                    } else if (typ == 4) { dst = GR;
#pragma unroll
                        for (int e = 0; e < 8; ++e) r[e] = x[e] * fsigmoid(x[e]);
                    } else {
                        const int dir = typ - 2; dst = dir ? KBK : KF; float* lf = (dir ? LFB : LFF) + off;
                        const float* lbp = LB + dir * 1024 + colb + bj * 128;
                        const f32x4 l0 = *(const f32x4*)lbp, l1 = *(const f32x4*)(lbp + 4);
                        float lg[8];
#pragma unroll
                        for (int e = 0; e < 8; ++e) { const float lb = e < 4 ? l0[e & 3] : l1[e & 3]; const float ez = __expf(-x[e]);
                            const float sg = frcp(1.f + ez), sgn = ez * sg;
                            lg[e] = __logf(lb + (1.f - lb) * sg); r[e] = (1.f - lb) * sgn; }
                        *(f32x4*)lf = (f32x4){lg[0], lg[1], lg[2], lg[3]}; *(f32x4*)(lf + 4) = (f32x4){lg[4], lg[5], lg[6], lg[7]};
                    }
                    u32x4 w; w.x = cvt_pk_bf16(r[0], r[1]); w.y = cvt_pk_bf16(r[2], r[3]); w.z = cvt_pk_bf16(r[4], r[5]); w.w = cvt_pk_bf16(r[6], r[7]);
                    *(u32x4*)(dst + off) = w;
                }
    }
};

__device__ __forceinline__ void transpose_item(const float* W, int K, int N, bf16_t* WT, LAS float* scr, int item, int lane, bool perm) {
    const int nblk = N / 32, kb = item / nblk, nb = item - kb * nblk, k0 = 64 * kb, n0 = 32 * nb;
#pragma unroll 8
    for (int i = 0; i < 32; ++i) { const int kk = 2 * i + (lane >> 5); scr[kk * 33 + (lane & 31)] = W[(size_t)(k0 + kk) * N + n0 + (lane & 31)]; }
    LDSW();
    int row0 = n0;
    if (perm) { const int half = n0 / FF, j0 = n0 - half * FF; row0 = (j0 >> 7) * 256 + half * 128 + (j0 & 127); }
    const int c = lane & 7;
#pragma unroll
    for (int j = 0; j < 4; ++j) { const int n = (lane >> 3) + 8 * j; const LAS float* s = scr + (8 * c) * 33 + n;
        u32x4 o; o.x = cvt_pk_bf16(s[0 * 33], s[1 * 33]); o.y = cvt_pk_bf16(s[2 * 33], s[3 * 33]); o.z = cvt_pk_bf16(s[4 * 33], s[5 * 33]); o.w = cvt_pk_bf16(s[6 * 33], s[7 * 33]);
        *(u32x4*)(WT + (size_t)(row0 + n) * K + k0 + 8 * c) = o; }
    LDSW();
}
__device__ __forceinline__ void ada_item(const float* w_ada, const float* c_ctx, const float* c, float* MODP, int item, int lane) {
    const int l = item / 576, r = item - l * 576, cgp = r >> 4, kc = r & 15;
    const int k = kc * 64 + lane;
    float s0 = c_ctx[k], s1 = c[k], s2 = c[1024 + k];
    s0 = s0 * fsigmoid(s0); s1 = s1 * fsigmoid(s1); s2 = s2 * fsigmoid(s2);
    f32x4 a0 = {0.f, 0.f, 0.f, 0.f}, a1 = a0, a2 = a0;
    const float* wp = w_ada + (size_t)l * 1024 * NADA + (size_t)(kc * 64) * NADA + cgp * 256 + 4 * lane;
#pragma unroll 8
    for (int kk = 0; kk < 64; ++kk) {
        const f32x4 w = *(const f32x4*)(wp + (size_t)kk * NADA);
        const float t0 = __shfl(s0, kk), t1 = __shfl(s1, kk), t2 = __shfl(s2, kk);
        a0 += w * t0; a1 += w * t1; a2 += w * t2;
    }
    float* o = MODP + (size_t)((l * 16 + kc) * 3) * NADA + cgp * 256 + 4 * lane;
    *(f32x4*)o = a0; *(f32x4*)(o + NADA) = a1; *(f32x4*)(o + 2 * NADA) = a2;
}

__device__ __forceinline__ void rw_phase(int G, int bid, int wave, int lane, const float* xp, const float* xs, float* xout, const float* OUTF,
                                         const float* modpost, const float* gpost, float wgt, bool has_post, bool x_from_in,
                                         const float* modpre, const float* gpre, bool has_pre, bf16_t* H) {
    for (int r = bid * 8 + wave; r < MT; r += G * 8) {
        const int grp = r < MP ? 0 : 1 + ((r - MP) >> 10);
        const float* xin = x_from_in ? (r < MP ? xp + (size_t)r * D : xs + (size_t)(r - MP) * D) : xout + (size_t)r * D;
        f32x4 x[4];
#pragma unroll
        for (int j = 0; j < 4; ++j) x[j] = *(const f32x4*)(xin + 4 * lane + 256 * j);
        if (has_post) {
            f32x4 o[4]; float ss = 0.f;
#pragma unroll
            for (int j = 0; j < 4; ++j) { o[j] = *(const f32x4*)(OUTF + (size_t)r * D + 4 * lane + 256 * j); ss += (o[j].x * o[j].x + o[j].y * o[j].y) + (o[j].z * o[j].z + o[j].w * o[j].w); }
            const float rs = rsqrtf(wave_sum(ss) * (1.f / D) + EPS) * wgt;
            const float* gt = modpost + grp * NADA + 2 * D;
#pragma unroll
            for (int j = 0; j < 4; ++j) { const f32x4 g4 = *(const f32x4*)(gt + 4 * lane + 256 * j), p4 = *(const f32x4*)(gpost + 4 * lane + 256 * j);
                x[j] = x[j] + g4 * (o[j] * rs * p4); *(f32x4*)(xout + (size_t)r * D + 4 * lane + 256 * j) = x[j]; }
        }
        if (has_pre) {
            float ss = 0.f;
#pragma unroll
            for (int j = 0; j < 4; ++j) ss += (x[j].x * x[j].x + x[j].y * x[j].y) + (x[j].z * x[j].z + x[j].w * x[j].w);
            const float rs = rsqrtf(wave_sum(ss) * (1.f / D) + EPS);
            const float* sh = modpre + grp * NADA; const float* sc = sh + D;
#pragma unroll
            for (int j = 0; j < 4; ++j) { const int c = 4 * lane + 256 * j; const f32x4 s4 = *(const f32x4*)(sh + c), c4 = *(const f32x4*)(sc + c), p4 = *(const f32x4*)(gpre + c);
                const f32x4 h = x[j] * rs * p4 * (c4 + 1.f) + s4;
                u32x2 w; w.x = cvt_pk_bf16(h.x, h.y); w.y = cvt_pk_bf16(h.z, h.w); *(u32x2*)(H + (size_t)r * D + c) = w; }
        }
    }
}
__device__ __forceinline__ void comb_phase(int G, int bid, int wave, int lane, const float* OF, const float* OB, const bf16_t* GR, const float* gn, bf16_t* AO) {
    for (int r = bid * 8 + wave; r < MT; r += G * 8) {
#pragma unroll
        for (int j = 0; j < 4; ++j) {
            const int c = 4 * lane + 256 * j; const size_t off = (size_t)r * D + c;
            const f32x4 o = *(const f32x4*)(OF + off) + *(const f32x4*)(OB + off);
            float ss = (o.x * o.x + o.y * o.y) + (o.z * o.z + o.w * o.w);
#pragma unroll
            for (int s = 1; s < 32; s <<= 1) ss += __shfl_xor(ss, s);
            const float rs = rsqrtf(ss * (1.f / 128.f) + EPS);
            const f32x4 g4 = *(const f32x4*)(gn + c); const u32x2 gg = *(const u32x2*)(GR + off);
            const float r0 = o.x * rs * g4.x * bf2f(gg.x & 0xffffu), r1 = o.y * rs * g4.y * bf2f(gg.x >> 16), r2 = o.z * rs * g4.z * bf2f(gg.y & 0xffffu), r3 = o.w * rs * g4.w * bf2f(gg.y >> 16);
            u32x2 w; w.x = cvt_pk_bf16(r0, r1); w.y = cvt_pk_bf16(r2, r3); *(u32x2*)(AO + off) = w;
        }
    }
}

constexpr int AT_KS = 72, AT_VS = 136, AT_VOFF = 128 * AT_KS * 2;
template <bool F32SRC>
__device__ __forceinline__ void attn_load_chunk(LAS unsigned char* lds, const void* Kg, const void* Vg, int tid) {
    LAS bf16_t* Ks = (LAS bf16_t*)lds; LAS bf16_t* Vt = (LAS bf16_t*)(lds + AT_VOFF);
#pragma unroll
    for (int i = 0; i < 2; ++i) {
        const int p = tid + 512 * i, key = p >> 3, c8 = p & 7;
        u32x4 kv, vv;
        if (F32SRC) {
            const float* kp = (const float*)Kg + (size_t)key * 256 + c8 * 8; const float* vp = (const float*)Vg + (size_t)key * 256 + c8 * 8;
            const f32x4 k0 = *(const f32x4*)kp, k1 = *(const f32x4*)(kp + 4), v0 = *(const f32x4*)vp, v1 = *(const f32x4*)(vp + 4);
            kv.x = cvt_pk_bf16(k0.x, k0.y); kv.y = cvt_pk_bf16(k0.z, k0.w); kv.z = cvt_pk_bf16(k1.x, k1.y); kv.w = cvt_pk_bf16(k1.z, k1.w);
            vv.x = cvt_pk_bf16(v0.x, v0.y); vv.y = cvt_pk_bf16(v0.z, v0.w); vv.z = cvt_pk_bf16(v1.x, v1.y); vv.w = cvt_pk_bf16(v1.z, v1.w);
        } else {
            kv = *(const u32x4*)((const bf16_t*)Kg + (size_t)key * 256 + c8 * 8); vv = *(const u32x4*)((const bf16_t*)Vg + (size_t)key * 256 + c8 * 8);
        }
        *(LAS u32x4*)(Ks + key * AT_KS + c8 * 8) = kv;
#pragma unroll
        for (int e = 0; e < 8; ++e) { const unsigned w = vv[e >> 1]; Vt[(c8 * 8 + e) * AT_VS + key] = (bf16_t)((e & 1) ? (w >> 16) : (w & 0xffffu)); }
    }
}
__device__ __forceinline__ void attn_phase(LAS unsigned char* lds, const bf16_t* Q, const bf16_t* KB, const bf16_t* VB, const float* ck, const float* cv, const float* sink,
                                           bf16_t* AO, int G, int bid, int tid, int lane, int wave) {
    const int fr = lane & 15, g = lane >> 4;
    LAS bf16_t* Ks = (LAS bf16_t*)lds; LAS bf16_t* Vt = (LAS bf16_t*)(lds + AT_VOFF);
    for (int u = bid; u < 256 + 1024; u += G) {
        const bool lat = u < 256;
        int b, h, qb, rowq0;
        if (lat) { b = u >> 7; h = (u >> 3) & 15; qb = u & 7; rowq0 = MP + b * 1024 + qb * 128; }
        else { const int v = u - 256; b = v >> 5; h = (v >> 1) & 15; qb = v & 1; rowq0 = b * 256 + qb * 128; }
        const int kvh = h >> 2, qq = 16 * wave + fr, row = rowq0 + qq;
        bf16x8 qf[2];
#pragma unroll
        for (int ks = 0; ks < 2; ++ks) qf[ks] = *(const bf16x8*)(Q + (size_t)row * D + h * 64 + ks * 32 + g * 8);
        float mrun = sink[h], lsum = (g == 0) ? 1.f : 0.f;
        f32x4 o[4];
#pragma unroll
        for (int i = 0; i < 4; ++i) o[i] = (f32x4){0.f, 0.f, 0.f, 0.f};
        const int nch = lat ? 5 : 2;
        for (int ci = 0; ci < nch; ++ci) {
            int mode = 1;
            if (lat && ci < 3) { const int blk = qb - 1 + ci; if (blk < 0 || blk > 7) continue; mode = ci; }
            __syncthreads();
            if (lat && ci >= 3) { const size_t off = (size_t)(b * 256 + (ci - 3) * 128) * 256 + kvh * 64; attn_load_chunk<true>(lds, ck + off, cv + off, tid); }
            else { const int r0 = lat ? MP + b * 1024 + (qb - 1 + ci) * 128 : b * 256 + ci * 128; const size_t off = (size_t)r0 * 256 + kvh * 64; attn_load_chunk<false>(lds, KB + off, VB + off, tid); }
            __syncthreads();
            f32x4 st[8];
#pragma unroll
            for (int kb = 0; kb < 8; ++kb) { st[kb] = (f32x4){0.f, 0.f, 0.f, 0.f};
#pragma unroll
                for (int ks = 0; ks < 2; ++ks) { const bf16x8 A = *(const LAS bf16x8*)(Ks + (kb * 16 + fr) * AT_KS + ks * 32 + g * 8); st[kb] = MFMA16(A, qf[ks], st[kb]); } }
            float cmax = -3.0e38f;
            int qv = qq; asm volatile("" : "+v"(qv));
#pragma unroll
            for (int kb = 0; kb < 8; ++kb)
#pragma unroll
                for (int j = 0; j < 4; ++j) { const int kk = kb * 16 + 4 * g + j; float s = st[kb][j] * 0.125f;
                    if (mode == 0 && kk < qv) s = -1e30f;
                    if (mode == 2 && kk > qv) s = -1e30f;
                    st[kb][j] = s; cmax = fmaxf(cmax, s); }
            cmax = fmaxf(cmax, __shfl_xor(cmax, 16)); cmax = fmaxf(cmax, __shfl_xor(cmax, 32));
            const float mnew = fmaxf(mrun, cmax), alpha = __expf(mrun - mnew);
            mrun = mnew; lsum *= alpha;
#pragma unroll
            for (int i = 0; i < 4; ++i) o[i] = o[i] * alpha;
#pragma unroll
            for (int kb = 0; kb < 8; ++kb)
#pragma unroll
                for (int j = 0; j < 4; ++j) { const float p = __expf(st[kb][j] - mnew); st[kb][j] = p; lsum += p; }
#pragma unroll
            for (int i = 0; i < 4; ++i) {
                const bf16x8 pb = mk8(cvt_pk_bf16(st[2 * i][0], st[2 * i][1]), cvt_pk_bf16(st[2 * i][2], st[2 * i][3]), cvt_pk_bf16(st[2 * i + 1][0], st[2 * i + 1][1]), cvt_pk_bf16(st[2 * i + 1][2], st[2 * i + 1][3]));
#pragma unroll
                for (int dvb = 0; dvb < 4; ++dvb) { const LAS bf16_t* vp = Vt + (dvb * 16 + fr) * AT_VS + i * 32 + 4 * g;
                    const u32x2 lo = *(const LAS u32x2*)vp, hi = *(const LAS u32x2*)(vp + 16);
                    o[dvb] = MFMA16(mk8(lo.x, lo.y, hi.x, hi.y), pb, o[dvb]); }
            }
        }
        lsum += __shfl_xor(lsum, 16); lsum += __shfl_xor(lsum, 32);
        const float inv = 1.f / lsum;
#pragma unroll
        for (int dvb = 0; dvb < 4; ++dvb) { u32x2 w; w.x = cvt_pk_bf16(o[dvb][0] * inv, o[dvb][1] * inv); w.y = cvt_pk_bf16(o[dvb][2] * inv, o[dvb][3] * inv);
            *(u32x2*)(AO + (size_t)row * D + h * 64 + dvb * 16 + 4 * g) = w; }
    }
}

constexpr int RC_QD = 0, RC_KI = 17408, RC_KET = 34816, RC_VT = 53248, RC_ST = 71680, RC_SEG = 106496, RC_DEC = 108544;
__device__ __forceinline__ void rec_phase(LAS unsigned char* lds, const bf16_t* QR, const bf16_t* VR, const bf16_t* KF, const bf16_t* KBK, float* LFF, float* LFB,
                                          const float* state_s, float* new_state, int G, int bid, int tid, int lane, int wave) {
    LAS bf16_t* Qd = (LAS bf16_t*)(lds + RC_QD); LAS bf16_t* Ki = (LAS bf16_t*)(lds + RC_KI); LAS bf16_t* KeT = (LAS bf16_t*)(lds + RC_KET);
    LAS bf16_t* Vt = (LAS bf16_t*)(lds + RC_VT); LAS bf16_t* St = (LAS bf16_t*)(lds + RC_ST);
    LAS float* SEG = (LAS float*)(lds + RC_SEG); LAS float* DEC = (LAS float*)(lds + RC_DEC);
    const int fr = lane & 15, g = lane >> 4, cb = wave & 3, vh = wave >> 2;
    const int kcol = tid & 127, seg = tid >> 7;
    int it, step;
    if (G >= 64) { if (bid < 32) { it = bid; step = 1 << 20; } else { it = bid; step = G - 32; } } else { it = bid; step = G; }
    for (; it < 544; it += step) {
        const bool samp = it < 32;
        int b, h, dir, T, rowbase;
        if (samp) { b = it >> 4; h = (it >> 1) & 7; dir = it & 1; T = 1024; rowbase = MP + b * 1024; }
        else { const int p = it - 32; b = p >> 4; h = (p >> 1) & 7; dir = p & 1; T = 256; rowbase = b * 256; }
        float* LFO = dir ? LFB : LFF; const bf16_t* KK = dir ? KBK : KF;
        const int col0 = h * 128;
        f32x4 S[8];
        if (samp) { const float* sp = state_s + (size_t)((b * 2 + dir) * 8 + h) * 16384;
#pragma unroll
            for (int vb = 0; vb < 8; ++vb)
#pragma unroll
                for (int j = 0; j < 4; ++j) S[vb][j] = sp[(wave * 16 + 4 * g + j) * 128 + vb * 16 + fr];
        } else {
#pragma unroll
            for (int vb = 0; vb < 8; ++vb) S[vb] = (f32x4){0.f, 0.f, 0.f, 0.f};
        }
        __syncthreads();
#pragma unroll
        for (int vb = 0; vb < 8; ++vb) { u32x2 w; w.x = cvt_pk_bf16(S[vb][0], S[vb][1]); w.y = cvt_pk_bf16(S[vb][2], S[vb][3]); *(LAS u32x2*)(St + (vb * 16 + fr) * 136 + wave * 16 + 4 * g) = w; }
        const int nchunk = T >> 6;
        for (int n = 0; n < nchunk; ++n) {
            const int s0 = seg * 16;
            const long rstep = dir ? -(long)D : (long)D;
            const size_t base = (size_t)(rowbase + (dir ? T - 1 - (64 * n + s0) : 64 * n + s0)) * D + col0 + kcol;
            float lf[16]; unsigned short qv[16], kv[16], vv[16];
#pragma unroll
            for (int i = 0; i < 16; ++i) lf[i] = LFO[(long)base + rstep * i];
#pragma unroll
            for (int i = 0; i < 16; ++i) { qv[i] = QR[(long)base + rstep * i]; kv[i] = KK[(long)base + rstep * i]; vv[i] = VR[(long)base + rstep * i]; }
#pragma unroll
            for (int i = 1; i < 16; ++i) lf[i] += lf[i - 1];
            SEG[seg * 128 + kcol] = lf[15];
            __syncthreads();
            const float t0 = SEG[kcol], t1 = SEG[128 + kcol], t2 = SEG[256 + kcol], t3 = SEG[384 + kcol];
            const float prefix = (seg > 0 ? t0 : 0.f) + (seg > 1 ? t1 : 0.f) + (seg > 2 ? t2 : 0.f), total = (t0 + t1) + (t2 + t3);
            float ke[16];
#pragma unroll
            for (int i = 0; i < 16; ++i) {
                const float bc = prefix + lf[i], q = bf2f(qv[i]), k = bf2f(kv[i]);
                const float qd = q * __expf(bc), ki = k * __expf(-bc); ke[i] = k * __expf(total - bc);
                const unsigned pk = cvt_pk_bf16(qd, ki);
                Qd[(s0 + i) * 136 + kcol] = (bf16_t)(pk & 0xffffu); Ki[(s0 + i) * 136 + kcol] = (bf16_t)(pk >> 16);
            }
            {
                u32x4 w0, w1;
                w0.x = cvt_pk_bf16(ke[0], ke[1]); w0.y = cvt_pk_bf16(ke[2], ke[3]); w0.z = cvt_pk_bf16(ke[4], ke[5]); w0.w = cvt_pk_bf16(ke[6], ke[7]);
                w1.x = cvt_pk_bf16(ke[8], ke[9]); w1.y = cvt_pk_bf16(ke[10], ke[11]); w1.z = cvt_pk_bf16(ke[12], ke[13]); w1.w = cvt_pk_bf16(ke[14], ke[15]);
                *(LAS u32x4*)(KeT + kcol * 72 + s0) = w0; *(LAS u32x4*)(KeT + kcol * 72 + s0 + 8) = w1;
                u32x4 x0, x1;
                x0.x = (unsigned)vv[0] | ((unsigned)vv[1] << 16); x0.y = (unsigned)vv[2] | ((unsigned)vv[3] << 16); x0.z = (unsigned)vv[4] | ((unsigned)vv[5] << 16); x0.w = (unsigned)vv[6] | ((unsigned)vv[7] << 16);
                x1.x = (unsigned)vv[8] | ((unsigned)vv[9] << 16); x1.y = (unsigned)vv[10] | ((unsigned)vv[11] << 16); x1.z = (unsigned)vv[12] | ((unsigned)vv[13] << 16); x1.w = (unsigned)vv[14] | ((unsigned)vv[15] << 16);
                *(LAS u32x4*)(Vt + kcol * 72 + s0) = x0; *(LAS u32x4*)(Vt + kcol * 72 + s0 + 8) = x1;
            }
            if (seg == 0) DEC[kcol] = __expf(total);
            __syncthreads();
            bf16x8 qd[4];
#pragma unroll
            for (int ks = 0; ks < 4; ++ks) qd[ks] = *(const LAS bf16x8*)(Qd + (cb * 16 + fr) * 136 + ks * 32 + g * 8);
            f32x4 at[4];
            int cv = cb * 16 + fr - 4 * g; asm volatile("" : "+v"(cv));
#pragma unroll
            for (int sb = 0; sb < 4; ++sb) { at[sb] = (f32x4){0.f, 0.f, 0.f, 0.f};
#pragma unroll
                for (int ks = 0; ks < 4; ++ks) { const bf16x8 A = *(const LAS bf16x8*)(Ki + (sb * 16 + fr) * 136 + ks * 32 + g * 8); at[sb] = MFMA16(A, qd[ks], at[sb]); }
#pragma unroll
                for (int j = 0; j < 4; ++j) if (sb * 16 + j > cv) at[sb][j] = 0.f;
            }
            bf16x8 P[2];
#pragma unroll
            for (int x = 0; x < 2; ++x) P[x] = mk8(cvt_pk_bf16(at[2 * x][0], at[2 * x][1]), cvt_pk_bf16(at[2 * x][2], at[2 * x][3]), cvt_pk_bf16(at[2 * x + 1][0], at[2 * x + 1][1]), cvt_pk_bf16(at[2 * x + 1][2], at[2 * x + 1][3]));
            {
                const int c = cb * 16 + fr; const int t = dir ? T - 1 - (64 * n + c) : 64 * n + c;
                float* orow = LFO + (size_t)(rowbase + t) * D + col0;
#pragma unroll
                for (int i = 0; i < 4; ++i) { const int vb = vh * 4 + i; f32x4 acc = {0.f, 0.f, 0.f, 0.f};
#pragma unroll
                    for (int x = 0; x < 2; ++x) { const LAS bf16_t* vp = Vt + (vb * 16 + fr) * 72 + x * 32 + 4 * g; const u32x2 lo = *(const LAS u32x2*)vp, hi = *(const LAS u32x2*)(vp + 16);
                        acc = MFMA16(mk8(lo.x, lo.y, hi.x, hi.y), P[x], acc); }
#pragma unroll
                    for (int ks = 0; ks < 4; ++ks) { const bf16x8 A = *(const LAS bf16x8*)(St + (vb * 16 + fr) * 136 + ks * 32 + g * 8); acc = MFMA16(A, qd[ks], acc); }
                    *(f32x4*)(orow + vb * 16 + 4 * g) = acc; }
            }
            {
                bf16x8 kef[2];
#pragma unroll
                for (int x = 0; x < 2; ++x) kef[x] = *(const LAS bf16x8*)(KeT + (wave * 16 + fr) * 72 + x * 32 + g * 8);
                const f32x4 dc = *(const LAS f32x4*)(DEC + wave * 16 + 4 * g);
#pragma unroll
                for (int vb = 0; vb < 8; ++vb) { f32x4 up = {0.f, 0.f, 0.f, 0.f};
#pragma unroll
                    for (int x = 0; x < 2; ++x) { const bf16x8 B = *(const LAS bf16x8*)(Vt + (vb * 16 + fr) * 72 + x * 32 + g * 8); up = MFMA16(kef[x], B, up); }
                    S[vb] = dc * S[vb] + up; }
            }
            __syncthreads();
#pragma unroll
            for (int vb = 0; vb < 8; ++vb) { u32x2 w; w.x = cvt_pk_bf16(S[vb][0], S[vb][1]); w.y = cvt_pk_bf16(S[vb][2], S[vb][3]); *(LAS u32x2*)(St + (vb * 16 + fr) * 136 + wave * 16 + 4 * g) = w; }
        }
        if (!samp) { float* sp = new_state + (size_t)((b * 2 + dir) * 8 + h) * 16384;
#pragma unroll
            for (int vb = 0; vb < 8; ++vb)
#pragma unroll
                for (int j = 0; j < 4; ++j) sp[(wave * 16 + 4 * g + j) * 128 + vb * 16 + fr] = S[vb][j];
        }
    }
}

struct Args { const float* in[20]; float* out; unsigned char* ws; int ph_lo, ph_hi; };
typedef const __attribute__((address_space(4))) Args* KArgs;
#define KA() ({ KArgs _p = (KArgs)__builtin_amdgcn_kernarg_segment_ptr(); asm volatile("" : "+s"(_p)); _p; })
__global__ void __launch_bounds__(512, 2) fwd_kernel(Args a_unused) {
    extern __shared__ __attribute__((aligned(16))) unsigned char lds_raw[];
    LAS unsigned char* lds = (LAS unsigned char*)lds_raw;
    cg::grid_group grid = cg::this_grid();
    const int G = gridDim.x, bid = blockIdx.x;
    int lo, hi; { KArgs ka = KA(); lo = ka->ph_lo; hi = ka->ph_hi; }
    int ph = 0;
#define PH_BEGIN if (ph >= lo && ph < hi) { KArgs ka = KA(); unsigned char* ws = ka->ws; (void)ws; int tid = threadIdx.x; asm volatile("" : "+v"(tid)); const int lane = tid & 63, wave = __builtin_amdgcn_readfirstlane(tid >> 6); (void)lane; (void)wave;
#define PH_END   if (ph + 1 < hi) grid.sync(); } ++ph;

    PH_BEGIN
    {
        LAS float* scr = (LAS float*)(lds + wave * 16384);
        const int gw = bid * 8 + wave, NGW = G * 8;
        constexpr int I_ADA = 1152, I_W1 = 16 * 176, I_W2 = 44 * 32, I_QKV = 16 * 48, I_AO = 16 * 32, I_RI = 16 * 160, I_RO = 16 * 32;
        constexpr int E1 = I_ADA, E2 = E1 + 4 * I_W1, E3 = E2 + 4 * I_W2, E4 = E3 + I_QKV, E5 = E4 + I_AO, E6 = E5 + I_RI, NITEMS = E6 + I_RO;
        for (int it = gw; it < NITEMS; it += NGW) {
            if (it < E1) { ada_item(ka->in[7], ka->in[6], ka->in[2], (float*)(ws + WS_MODP), it, lane); continue; }
            const float* W; bf16_t* WT; int K, N, item; bool perm = false;
            if (it < E2) { const int r = it - E1, w = r / I_W1; item = r - w * I_W1; W = ka->in[11] + (size_t)w * D * NFF1; WT = (bf16_t*)(ws + WS_W1) + (size_t)w * NFF1 * D; K = D; N = NFF1; perm = true; }
            else if (it < E3) { const int r = it - E2, w = r / I_W2; item = r - w * I_W2; W = ka->in[12] + (size_t)w * FF * D; WT = (bf16_t*)(ws + WS_W2) + (size_t)w * D * FF; K = FF; N = D; }
            else if (it < E4) { item = it - E3; W = ka->in[13]; WT = (bf16_t*)(ws + WS_WQKV); K = D; N = NQKV; }
            else if (it < E5) { item = it - E4; W = ka->in[14]; WT = (bf16_t*)(ws + WS_WAO); K = D; N = D; }
            else if (it < E6) { item = it - E5; W = ka->in[16]; WT = (bf16_t*)(ws + WS_WRI); K = D; N = NREC; }
            else { item = it - E6; W = ka->in[19]; WT = (bf16_t*)(ws + WS_WRO); K = D; N = D; }
            transpose_item(W, K, N, WT, scr, item, lane, perm);
        }
    }
    PH_END
    PH_BEGIN
    {
        const float* b_ada = ka->in[8]; const float* rec_lb = ka->in[17];
        const float* MODP = (const float*)(ws + WS_MODP); float* MOD = (float*)(ws + WS_MOD); float* LB = (float*)(ws + WS_LB);
        const int gt = bid * 512 + tid, NT = G * 512;
        for (int idx = gt; idx < 2 * 3 * NADA; idx += NT) {
            const int l = idx / (3 * NADA), r = idx - l * 3 * NADA, g = r / NADA, n = r - g * NADA;
            float s = b_ada[l * NADA + n];
#pragma unroll
            for (int kc = 0; kc < 16; ++kc) s += MODP[(size_t)((l * 16 + kc) * 3 + g) * NADA + n];
            MOD[idx] = s;
        }
        for (int idx = gt; idx < 2048; idx += NT) { const int dir = idx >> 10, i = idx & 1023; const float l0 = rec_lb[(dir * 2 + 0) * 1024 + i], l1 = rec_lb[(dir * 2 + 1) * 1024 + i]; LB[idx] = frcp(1.f + __expf(l0 - l1)); }
    }
    PH_END
    PH_BEGIN
    rw_phase(G, bid, wave, lane, ka->in[0], ka->in[1], ka->out, (const float*)(ws + WS_OUTF), (const float*)(ws + WS_MOD), ka->in[10], 0.f, false, true, (const float*)(ws + WS_MOD), ka->in[9], true, (bf16_t*)(ws + WS_H));
    PH_END

    for (int l = 0; l < 2; ++l) {
        for (int s = 0; s < 3; ++s) {
            if (s != 1) {
                PH_BEGIN
                { const int f = l * 2 + (s >> 1);
                  pg8::Gemm g{(const bf16_t*)(ws + WS_H), (const bf16_t*)(ws + WS_W1) + (size_t)f * NFF1 * D, MT, NFF1, D}; pg8::StaticOrder S; S.init(MT, NFF1, G, bid); EpiSwiGLU E{(bf16_t*)(ws + WS_ACT)};
                  pg8::gemm_phase<EpiSwiGLU, pg8::StaticOrder, true, true>(lds, g, S, E); }
                PH_END
            } else if (l == 0) {
                PH_BEGIN
                { pg8::Gemm g{(const bf16_t*)(ws + WS_H), (const bf16_t*)(ws + WS_WQKV), MT, NQKV, D}; pg8::StaticOrder S; S.init(MT, NQKV, G, bid);
                  EpiQKV E{ws, ka->out};
                  pg8::gemm_phase<EpiQKV, pg8::StaticOrder, true, true>(lds, g, S, E); }
                PH_END
                PH_BEGIN
                attn_phase(lds, (const bf16_t*)(ws + WS_Q), (const bf16_t*)(ws + WS_KB), (const bf16_t*)(ws + WS_VB), ka->in[3], ka->in[4], ka->in[15], (bf16_t*)(ws + WS_AO), G, bid, tid, lane, wave);
                PH_END
            } else {
                PH_BEGIN
                { pg8::Gemm g{(const bf16_t*)(ws + WS_H), (const bf16_t*)(ws + WS_WRI), MT, NREC, D}; pg8::StaticOrder S; S.init(MT, NREC, G, bid);
                  EpiRecIn E{ws};
                  pg8::gemm_phase<EpiRecIn, pg8::StaticOrder, true, true>(lds, g, S, E); }
                PH_END
                PH_BEGIN
                { float* ns_out = ka->out + (size_t)MT * D + (size_t)2 * MP * 256;
                  rec_phase(lds, (const bf16_t*)(ws + WS_QR), (const bf16_t*)(ws + WS_VR), (const bf16_t*)(ws + WS_KF), (const bf16_t*)(ws + WS_KBK), (float*)(ws + WS_LFF), (float*)(ws + WS_LFB), ka->in[5], ns_out, G, bid, tid, lane, wave); }
                PH_END
                PH_BEGIN
                comb_phase(G, bid, wave, lane, (const float*)(ws + WS_LFF), (const float*)(ws + WS_LFB), (const bf16_t*)(ws + WS_GR), ka->in[18], (bf16_t*)(ws + WS_QR));
                PH_END
            }
            PH_BEGIN
            { pg8::StaticOrder S; S.init(MT, D, G, bid); EpiF32 E{(float*)(ws + WS_OUTF)};
              if (s != 1) { pg8::Gemm g{(const bf16_t*)(ws + WS_ACT), (const bf16_t*)(ws + WS_W2) + (size_t)(l * 2 + (s >> 1)) * D * FF, MT, D, FF};
                  pg8::gemm_phase<EpiF32, pg8::StaticOrder, true, true>(lds, g, S, E); }
              else { pg8::Gemm g{(const bf16_t*)(ws + (l == 0 ? WS_AO : WS_QR)), (const bf16_t*)(ws + (l == 0 ? WS_WAO : WS_WRO)), MT, D, D};
                  pg8::gemm_phase<EpiF32, pg8::StaticOrder, true, true>(lds, g, S, E); } }
            PH_END
            PH_BEGIN
            {
                const bool last = (l == 1 && s == 2);
                const int nl = last ? 0 : ((s == 2) ? l + 1 : l), ns = (s == 2) ? 0 : s + 1;
                const float* MOD = (const float*)(ws + WS_MOD);
                rw_phase(G, bid, wave, lane, ka->in[0], ka->in[1], ka->out, (const float*)(ws + WS_OUTF), MOD + (size_t)l * 3 * NADA + s * 3 * D, ka->in[10] + (size_t)(l * 3 + s) * D, (s == 1) ? 1.f : 0.5f, true, (l == 0 && s == 0),
                         MOD + (size_t)nl * 3 * NADA + ns * 3 * D, ka->in[9] + (size_t)(nl * 3 + ns) * D, !last, (bf16_t*)(ws + WS_H));
            }
            PH_END
        }
    }
#undef PH_BEGIN
#undef PH_END
}

extern "C" void kernel_launch(void* const* d_in, const int* in_sizes, int n_in, void* d_out, int out_size, void* d_ws, size_t ws_size, hipStream_t stream) {
    static int grid = 0;
    if (grid == 0) {
        int dev = 0, cus = 0, per_cu = 0;
        if (n_in != 20 || ws_size < WS_END) { fprintf(stderr, "kernel_launch: unexpected n_in %d / ws_size %zu (need %zu)\n", n_in, ws_size, (size_t)WS_END); grid = -1; return; }
        if (hipGetDevice(&dev) != hipSuccess || hipDeviceGetAttribute(&cus, hipDeviceAttributeMultiprocessorCount, dev) != hipSuccess) { grid = -1; return; }
        if (hipFuncSetAttribute((const void*)fwd_kernel, hipFuncAttributeMaxDynamicSharedMemorySize, LDS_BYTES) != hipSuccess) { fprintf(stderr, "kernel_launch: hipFuncSetAttribute failed\n"); grid = -1; return; }
        if (hipOccupancyMaxActiveBlocksPerMultiprocessor(&per_cu, (const void*)fwd_kernel, 512, LDS_BYTES) != hipSuccess || per_cu < 1) { fprintf(stderr, "kernel_launch: occupancy query gave %d\n", per_cu); per_cu = 1; }
        (void)hipGetLastError();
        grid = cus * per_cu;
    }
    if (grid < 0) return;
    Args a{};
    for (int i = 0; i < 20; ++i) a.in[i] = (const float*)d_in[i];
    a.out = (float*)d_out; a.ws = (unsigned char*)d_ws;
#if MK_MULTI
    for (int p = 0; p < NPHASES; ++p) { a.ph_lo = p; a.ph_hi = p + 1; void* args[] = {&a};
        hipError_t e = hipLaunchCooperativeKernel((const void*)fwd_kernel, dim3(grid), dim3(512), args, LDS_BYTES, stream);
        if (e != hipSuccess) { fprintf(stderr, "launch %d failed: %s\n", p, hipGetErrorString(e)); break; } }
#else
    a.ph_lo = 0; a.ph_hi = NPHASES; void* args[] = {&a};
    hipError_t e = hipLaunchCooperativeKernel((const void*)fwd_kernel, dim3(grid), dim3(512), args, LDS_BYTES, stream);
    if (e != hipSuccess) fprintf(stderr, "cooperative launch failed: %s (grid %d)\n", hipGetErrorString(e), grid);
#endif
}
```

```cpp
#include <hip/hip_runtime.h>
#include <hip/hip_cooperative_groups.h>
#include <cstdio>
#include <cstdint>
namespace cg = cooperative_groups;
namespace pg8 {
#define PG8_LAS __attribute__((address_space(3)))
typedef unsigned short bf16_t;
typedef short bf16x8 __attribute__((ext_vector_type(8)));
typedef float f32x4 __attribute__((ext_vector_type(4)));
typedef unsigned u32x4 __attribute__((ext_vector_type(4)));
constexpr int BM = 256, BK = 64, HALF = 128, HTB = HALF * BK * 2  , STAGE_BYTES = 8 * HTB, NXCD = 8, WGM = 8;

__host__ __device__ __forceinline__ int lds_byte(int r, int c) { const int st = (r >> 4) * 2 + (c >> 5), rr = r & 15, cc = c & 31, ob = rr * 64 + cc * 2; return st * 1024 + (ob ^ (((ob >> 9) & 1) << 5)); }
__host__ __device__ __forceinline__ void stage_rc(int b, int& R, int& C) { const int st = b / 1024, sb = b % 1024, swz = sb ^ (((sb >> 9) & 1) << 5); R = (st >> 1) * 16 + swz / 64; C = (st & 1) * 32 + (swz % 64) / 2; }
__host__ __device__ __forceinline__ int perm32(int rho) { const int n = rho >> 4, i = rho & 15; return 8 * (i >> 2) + 4 * n + (i & 3); }

struct Unit { int pm, pn; };
struct Gemm { const bf16_t* A; const bf16_t* Bt; int M, N, K; };

struct StaticOrder {
    int nM, nN, nwg, G, c;
    __host__ __device__ void init(int M, int N, int G_, int c_) { nM = M / BM; nN = N / BM; nwg = nM * nN; G = G_; c = c_; }
    __host__ __device__ bool next(int i, Unit& u) const {
        const long L = (long)i * G + c; if (L >= nwg) return false;
        int wgid = (int)L; { const int q = nwg / NXCD, r = nwg % NXCD, xcd = wgid % NXCD, off = wgid / NXCD; wgid = (xcd < r ? xcd * (q + 1) : r * (q + 1) + (xcd - r) * q) + off; }
        const int nig = WGM * nN, gid = wgid / nig, fm = gid * WGM, gsz = (nM - fm) < WGM ? (nM - fm) : WGM;
        u.pm = fm + ((wgid % nig) % gsz); u.pn = (wgid % nig) / gsz; return true;
    }
    __device__ __forceinline__ void a_ready(const Unit&) const {}
    __device__ __forceinline__ void done(const Unit&) const {}
};

__device__ __forceinline__ unsigned cvt_pk_bf16(float lo, float hi) { unsigned r; asm volatile("v_cvt_pk_bf16_f32 %0, %1, %2" : "=v"(r) : "v"(lo), "v"(hi)); return r; }
template <class Epi, class Sched, bool ALIGN_EPI = false, bool SP2 = false>
__device__ __forceinline__ void gemm_phase(PG8_LAS unsigned char* lds, const Gemm g, const Sched& S, const Epi& E) {
    int tid_l = threadIdx.x; asm volatile("" : "+v"(tid_l));
    const int tid = tid_l, wid = __builtin_amdgcn_readfirstlane(tid >> 6), lane = tid & 63, wr = wid >> 2, wc = wid & 3, fr = lane & 15, fq = lane >> 4;
    const int K = g.K, nt = K / BK;
    unsigned voffA[2], voffB[2];
#pragma unroll
    for (int i = 0; i < 2; ++i) { int R, C; stage_rc(tid * 16 + i * 8192, R, C); const int Rb = Epi::PERM ? ((R & ~31) + perm32(R & 31)) : R;
        voffA[i] = (unsigned)(R * K + C) * 2u; voffB[i] = (unsigned)(Rb * K + C) * 2u; }
    const size_t kstep = (size_t)(BK * 2);
    const size_t hstep = (size_t)HALF * K * 2;
    const size_t tstep = 2 * hstep;
    const unsigned ldsw = (unsigned)wid * 1024u;
    const int aoff = lds_byte(wr * 64 + fr, fq * 8), boff = lds_byte(wc * 32 + fr, fq * 8);
#define PG8_SA(b, h) (((b) * 2 + (h)) * HTB)
#define PG8_SB(b, h) ((4 + (b) * 2 + (h)) * HTB)
#define PG8_STAGE(bufoff, gbase, voff) do { _Pragma("unroll") for (int _i = 0; _i < 2; ++_i) \
        __builtin_amdgcn_global_load_lds((const unsigned*)((const char*)(gbase) + (voff)[_i]), (PG8_LAS unsigned*)(lds + (bufoff) + ldsw + _i * 8192), 16, 0, 0); } while (0)
#define PG8_LDA(dst, b, h) do { _Pragma("unroll") for (int m = 0; m < 4; ++m) _Pragma("unroll") for (int k = 0; k < 2; ++k) dst[m][k] = *(const PG8_LAS bf16x8*)(lds + PG8_SA(b, h) + aoff + m * 2048 + k * 1024); } while (0)
#define PG8_LDB(dst, b, h) do { _Pragma("unroll") for (int n = 0; n < 2; ++n) _Pragma("unroll") for (int k = 0; k < 2; ++k) dst[n][k] = *(const PG8_LAS bf16x8*)(lds + PG8_SB(b, h) + boff + n * 2048 + k * 1024); } while (0)
#define PG8_MMA(ai, bj, At, Bt) do { __builtin_amdgcn_s_setprio(1); _Pragma("unroll") for (int m = 0; m < 4; ++m) _Pragma("unroll") for (int n = 0; n < 2; ++n) _Pragma("unroll") for (int k = 0; k < 2; ++k) \
        acc[ai][bj][m][n] = __builtin_amdgcn_mfma_f32_16x16x32_bf16(Bt[n][k], At[m][k], acc[ai][bj][m][n], 0, 0, 0); __builtin_amdgcn_s_setprio(0); } while (0)
#define PG8_WAIT_V(n) asm volatile("s_waitcnt vmcnt(" #n ")" ::: "memory")
#define PG8_WAIT_L(n) asm volatile("s_waitcnt lgkmcnt(" #n ")" ::: "memory")
#define PG8_BAR __builtin_amdgcn_s_barrier()
#define PG8_SCHED __builtin_amdgcn_sched_barrier(0)
    Unit cur, nxt; int ui = 0;
    if (!S.next(0, cur)) return;
    f32x4 acc[2][2][4][2];
#pragma unroll
    for (int a = 0; a < 2; ++a)
#pragma unroll
        for (int b = 0; b < 2; ++b)
#pragma unroll
            for (int m = 0; m < 4; ++m)
#pragma unroll
                for (int n = 0; n < 2; ++n) acc[a][b][m][n] = (f32x4){0.f, 0.f, 0.f, 0.f};
    bf16x8 At[4][2], B0[2][2], B1[2][2];
    const char* cA = (const char*)g.A + (size_t)cur.pm * tstep; const char* cB = (const char*)g.Bt + (size_t)cur.pn * tstep;
    S.a_ready(cur);
    if constexpr (SP2) {
        PG8_STAGE(PG8_SB(0, 0), cB, voffB); PG8_STAGE(PG8_SB(0, 1), cB + hstep, voffB); PG8_STAGE(PG8_SA(0, 0), cA, voffA); PG8_STAGE(PG8_SA(0, 1), cA + hstep, voffA);
        if (wr == 1) PG8_BAR;
        PG8_WAIT_V(2); PG8_BAR;
        PG8_STAGE(PG8_SB(1, 0), cB + kstep, voffB); PG8_STAGE(PG8_SA(1, 0), cA + kstep, voffA); PG8_STAGE(PG8_SB(1, 1), cB + hstep + kstep, voffB);
        PG8_WAIT_V(6); PG8_BAR;
    } else {
        PG8_STAGE(PG8_SB(0, 0), cB, voffB); PG8_STAGE(PG8_SA(0, 0), cA, voffA); PG8_STAGE(PG8_SB(0, 1), cB + hstep, voffB); PG8_STAGE(PG8_SA(0, 1), cA + hstep, voffA);
        if (wr == 1) PG8_BAR;
        PG8_WAIT_V(4); PG8_BAR;
        PG8_STAGE(PG8_SB(1, 0), cB + kstep, voffB); PG8_STAGE(PG8_SA(1, 0), cA + kstep, voffA); PG8_STAGE(PG8_SB(1, 1), cB + hstep + kstep, voffB);
        PG8_WAIT_V(6); PG8_BAR;
    }
    for (;;) {
        const bool has_next = S.next(ui + 1, nxt);
        const char* nA = has_next ? (const char*)g.A + (size_t)nxt.pm * tstep : cA; const char* nB = has_next ? (const char*)g.Bt + (size_t)nxt.pn * tstep : cB;
        for (int t = 0; t < nt; t += 2) {
            const bool last = (t == nt - 2);
            const char* a1 = cA + (size_t)(t + 1) * kstep;
            const char* a2 = last ? nA : cA + (size_t)(t + 2) * kstep; const char* b2 = last ? nB : cB + (size_t)(t + 2) * kstep;
            const char* a3 = a2 + kstep; const char* b3 = b2 + kstep;
            if (last && has_next) S.a_ready(nxt);
            if constexpr (SP2) {
            PG8_LDB(B0, 0, 0); PG8_LDB(B1, 0, 1); PG8_SCHED; PG8_LDA(At, 0, 0); PG8_STAGE(PG8_SA(1, 1), a1 + hstep, voffA);
            PG8_WAIT_V(8); PG8_WAIT_L(0); PG8_BAR; PG8_MMA(0, 0, At, B0); PG8_MMA(0, 1, At, B1); PG8_BAR; PG8_SCHED;
            PG8_LDA(At, 0, 1); PG8_STAGE(PG8_SB(0, 0), b2, voffB); PG8_STAGE(PG8_SB(0, 1), b2 + hstep, voffB); PG8_STAGE(PG8_SA(0, 0), a2, voffA);
            PG8_WAIT_V(8); PG8_WAIT_L(0); PG8_BAR; PG8_MMA(1, 0, At, B0); PG8_MMA(1, 1, At, B1); PG8_BAR; PG8_SCHED;
            PG8_LDB(B0, 1, 0); PG8_LDB(B1, 1, 1); PG8_SCHED; PG8_LDA(At, 1, 0); PG8_STAGE(PG8_SA(0, 1), a2 + hstep, voffA);
            PG8_WAIT_V(8); PG8_WAIT_L(0); PG8_BAR; PG8_MMA(0, 0, At, B0); PG8_MMA(0, 1, At, B1); PG8_BAR; PG8_SCHED;
            PG8_LDA(At, 1, 1); PG8_STAGE(PG8_SB(1, 0), b3, voffB); PG8_STAGE(PG8_SB(1, 1), b3 + hstep, voffB); PG8_STAGE(PG8_SA(1, 0), a3, voffA);
            PG8_WAIT_V(8); PG8_WAIT_L(0); PG8_BAR; PG8_MMA(1, 0, At, B0); PG8_MMA(1, 1, At, B1); PG8_BAR; PG8_SCHED;
            } else {
            PG8_LDB(B0, 0, 0); PG8_SCHED; PG8_LDA(At, 0, 0); PG8_STAGE(PG8_SA(1, 1), a1 + hstep, voffA);
            PG8_WAIT_L(8); PG8_BAR; PG8_WAIT_L(0); PG8_MMA(0, 0, At, B0); PG8_BAR; PG8_SCHED;
            PG8_LDB(B1, 0, 1); PG8_STAGE(PG8_SB(0, 0), b2, voffB);
            PG8_BAR; PG8_WAIT_L(0); PG8_MMA(0, 1, At, B1); PG8_BAR;
            PG8_LDA(At, 0, 1); PG8_STAGE(PG8_SA(0, 0), a2, voffA);
            PG8_BAR; PG8_WAIT_L(0); PG8_MMA(1, 0, At, B0); PG8_BAR; PG8_SCHED;
            PG8_STAGE(PG8_SB(0, 1), b2 + hstep, voffB);
            PG8_WAIT_V(6); PG8_BAR; PG8_MMA(1, 1, At, B1); PG8_BAR;
            PG8_LDB(B0, 1, 0); PG8_SCHED; PG8_LDA(At, 1, 0); PG8_STAGE(PG8_SA(0, 1), a2 + hstep, voffA);
            PG8_WAIT_L(8); PG8_BAR; PG8_WAIT_L(0); PG8_MMA(0, 0, At, B0); PG8_BAR; PG8_SCHED;
            PG8_LDB(B1, 1, 1); PG8_STAGE(PG8_SB(1, 0), b3, voffB);
            PG8_BAR; PG8_WAIT_L(0); PG8_MMA(0, 1, At, B1); PG8_BAR;
            PG8_LDA(At, 1, 1); PG8_STAGE(PG8_SA(1, 0), a3, voffA);
            PG8_BAR; PG8_WAIT_L(0); PG8_MMA(1, 0, At, B0); PG8_BAR; PG8_SCHED;
            PG8_STAGE(PG8_SB(1, 1), b3 + hstep, voffB);
            PG8_WAIT_V(6); PG8_BAR; PG8_MMA(1, 1, At, B1); PG8_BAR;
            }
        }
        if constexpr (ALIGN_EPI) { if (wr == 0) PG8_BAR; }
        if constexpr (!Epi::AFTER_DRAIN) { E(acc, cur, wr, wc, fr, fq); S.done(cur); }
        if (!has_next) break;
#pragma unroll
        for (int a = 0; a < 2; ++a)
#pragma unroll
            for (int b = 0; b < 2; ++b)
#pragma unroll
                for (int m = 0; m < 4; ++m)
#pragma unroll
                    for (int n = 0; n < 2; ++n) acc[a][b][m][n] = (f32x4){0.f, 0.f, 0.f, 0.f};
        cur = nxt; cA = nA; cB = nB; ++ui;
        if constexpr (ALIGN_EPI) { if (wr == 1) PG8_BAR; }
    }
    PG8_WAIT_V(0);
    if constexpr (!ALIGN_EPI) { if (wr == 0) PG8_BAR; }
    PG8_BAR;
    if constexpr (Epi::AFTER_DRAIN) { E.fused(acc, cur, wr, wc, fr, fq, lds, wid, lane); S.done(cur); }
#undef PG8_SA
#undef PG8_SB
#undef PG8_STAGE
#undef PG8_LDA
#undef PG8_LDB
#undef PG8_MMA
#undef PG8_WAIT_V
#undef PG8_WAIT_L
#undef PG8_BAR
#undef PG8_SCHED
}
}

#ifndef MK_MULTI
#define MK_MULTI 0
#endif
#ifndef REP_GEMM
#define REP_GEMM 1
#endif
#ifndef REP_SYNC
#define REP_SYNC 1
#endif
#ifndef REP_P0
#define REP_P0 1
#endif
#ifndef REP_MIX
#define REP_MIX 1
#endif
#define LAS __attribute__((address_space(3)))
typedef unsigned short bf16_t;
typedef short bf16x8 __attribute__((ext_vector_type(8)));
typedef float f32x4 __attribute__((ext_vector_type(4)));
typedef unsigned u32x4 __attribute__((ext_vector_type(4)));
typedef unsigned u32x2 __attribute__((ext_vector_type(2)));
using pg8::cvt_pk_bf16;

constexpr int D = 1024, MP = 8192, MS = 2048, MT = MP + MS, FF = 2816, NFF1 = 2 * FF, NQKV = 1536, NREC = 5120, NADA = 9216;
constexpr float EPS = 1e-6f;
constexpr int LDS_BYTES = 147456;
constexpr int NPHASES = 24;

constexpr size_t MiB = 1u << 20;
constexpr size_t WS_BAR = 0, WS_BAR_BYTES = 16384;
constexpr int LDS_MISC_OFF = 131072 + 320;
constexpr size_t WS_MODP = 1 * MiB;
constexpr size_t WS_MOD = 5 * MiB;
constexpr size_t WS_LB = 6 * MiB;
constexpr size_t WS_W1 = 8 * MiB;
constexpr size_t WS_W2 = 52 * MiB;
constexpr size_t WS_WQKV = 74 * MiB, WS_WAO = 77 * MiB, WS_WRI = 79 * MiB, WS_WRO = 89 * MiB;
constexpr size_t WS_H = 91 * MiB;
constexpr size_t WS_OUTF = 111 * MiB;
constexpr size_t WS_BIG = 151 * MiB;
constexpr size_t WS_ACT = WS_BIG;
constexpr size_t WS_Q = WS_BIG, WS_KB = WS_BIG + 20 * MiB, WS_VB = WS_BIG + 25 * MiB, WS_AO = WS_BIG + 30 * MiB;
constexpr size_t WS_QR = WS_BIG, WS_VR = WS_BIG + 20 * MiB, WS_KF = WS_BIG + 40 * MiB, WS_KBK = WS_BIG + 60 * MiB, WS_GR = WS_BIG + 80 * MiB;
constexpr size_t WS_LFF = WS_BIG + 100 * MiB, WS_LFB = WS_BIG + 140 * MiB;
constexpr size_t WS_END = WS_BIG + 180 * MiB;

__device__ __forceinline__ float bf2f(unsigned u16) { return __builtin_bit_cast(float, u16 << 16); }
__device__ __forceinline__ float wave_sum(float v) {
#pragma unroll
    for (int o = 1; o < 64; o <<= 1) v += __shfl_xor(v, o);
    return v;
}
__device__ __forceinline__ float frcp(float x) { return __builtin_amdgcn_rcpf(x); }
__device__ __forceinline__ float fsigmoid(float x) { return frcp(1.f + __expf(-x)); }
__device__ __forceinline__ bf16x8 mk8(unsigned a, unsigned b, unsigned c, unsigned d) { u32x4 t = {a, b, c, d}; return __builtin_bit_cast(bf16x8, t); }
#define MFMA16(a, b, c) __builtin_amdgcn_mfma_f32_16x16x32_bf16((a), (b), (c), 0, 0, 0)
#define LDSW() asm volatile("s_waitcnt lgkmcnt(0)" ::: "memory")

using pg8::Unit;
struct EpiSwiGLU {
    static constexpr bool PERM = true, AFTER_DRAIN = false;
    bf16_t* O;
    __device__ __forceinline__ void operator()(const f32x4 (&acc)[2][2][4][2], const Unit& u, int wr, int wc, int fr, int fq) const {
        const int row0 = u.pm * 256 + wr * 64 + fr, col0 = u.pn * 128 + wc * 32 + 8 * fq;
#pragma unroll
        for (int ai = 0; ai < 2; ++ai)
#pragma unroll
            for (int m = 0; m < 4; ++m) {
                bf16_t* p = O + (size_t)(row0 + ai * 128 + m * 16) * FF + col0;
                float r[8];
#pragma unroll
                for (int n = 0; n < 2; ++n)
#pragma unroll
                    for (int j = 0; j < 4; ++j) { const float av = acc[ai][0][m][n][j], bv = acc[ai][1][m][n][j]; r[n * 4 + j] = av * bv * fsigmoid(av); }
                u32x4 w; w.x = cvt_pk_bf16(r[0], r[1]); w.y = cvt_pk_bf16(r[2], r[3]); w.z = cvt_pk_bf16(r[4], r[5]); w.w = cvt_pk_bf16(r[6], r[7]);
                *(u32x4*)p = w;
            }
    }
};
struct EpiF32 {
    static constexpr bool PERM = true, AFTER_DRAIN = false;
    float* O;
    __device__ __forceinline__ void operator()(const f32x4 (&acc)[2][2][4][2], const Unit& u, int wr, int wc, int fr, int fq) const {
        const int row0 = u.pm * 256 + wr * 64 + fr, col0 = u.pn * 256 + wc * 32 + 8 * fq;
#pragma unroll
        for (int ai = 0; ai < 2; ++ai)
#pragma unroll
            for (int m = 0; m < 4; ++m)
#pragma unroll
                for (int bj = 0; bj < 2; ++bj) {
                    float* p = O + (size_t)(row0 + ai * 128 + m * 16) * D + col0 + bj * 128;
                    *(f32x4*)p = acc[ai][bj][m][0]; *(f32x4*)(p + 4) = acc[ai][bj][m][1];
                }
    }
};
struct EpiQKV {
    static constexpr bool PERM = false, AFTER_DRAIN = false;
    unsigned char* ws; float* out;
    __device__ __forceinline__ void operator()(const f32x4 (&acc)[2][2][4][2], const Unit& u, int wr, int wc, int fr, int fq) const {
        bf16_t* Q = (bf16_t*)(ws + WS_Q); bf16_t* KB = (bf16_t*)(ws + WS_KB); bf16_t* VB = (bf16_t*)(ws + WS_VB); float* ck_out = out + (size_t)MT * D; float* cv_out = ck_out + (size_t)MP * 256;
        const int row0 = u.pm * 256 + wr * 64 + fr;
        const bool samp = u.pm >= 32, rope = samp && (u.pn <= 4);
        float inv[4];
#pragma unroll
        for (int j = 0; j < 4; ++j) inv[j] = exp2f(-(float)(4 * fq + j) * (13.287712379549449f / 16.f));
#pragma unroll
        for (int ai = 0; ai < 2; ++ai)
#pragma unroll
            for (int m = 0; m < 4; ++m) {
                const int r = row0 + ai * 128 + m * 16;
                float cs[4], sn[4];
                if (rope) {
                    const int t = (r - MP) & 1023; const float pos = (float)((wc & 1) ? (t & 63) : (t >> 6));
#pragma unroll
                    for (int j = 0; j < 4; ++j) { const float ang = pos * inv[j]; cs[j] = __cosf(ang); sn[j] = __sinf(ang); }
                }
#pragma unroll
                for (int bj = 0; bj < 2; ++bj) {
                    f32x4 v0 = acc[ai][bj][m][0], v1 = acc[ai][bj][m][1];
                    if (rope) {
#pragma unroll
                        for (int j = 0; j < 4; ++j) { const float x1 = v0[j], x2 = v1[j]; v0[j] = x1 * cs[j] - x2 * sn[j]; v1[j] = x1 * sn[j] + x2 * cs[j]; }
                    }
                    const int cc = 128 * bj + 32 * wc + 4 * fq;
                    u32x2 w0, w1; w0.x = cvt_pk_bf16(v0[0], v0[1]); w0.y = cvt_pk_bf16(v0[2], v0[3]); w1.x = cvt_pk_bf16(v1[0], v1[1]); w1.y = cvt_pk_bf16(v1[2], v1[3]);
                    if (u.pn < 4) { bf16_t* p = Q + (size_t)r * D + u.pn * 256 + cc; *(u32x2*)p = w0; *(u32x2*)(p + 16) = w1; }
                    else {
                        bf16_t* p = (u.pn == 4 ? KB : VB) + (size_t)r * 256 + cc; *(u32x2*)p = w0; *(u32x2*)(p + 16) = w1;
                        if (!samp) { float* c = (u.pn == 4 ? ck_out : cv_out) + (size_t)r * 256 + cc; *(f32x4*)c = v0; *(f32x4*)(c + 16) = v1; }
                    }
                }
            }
    }
};
struct EpiRecIn {
    static constexpr bool PERM = true, AFTER_DRAIN = false;
    unsigned char* ws;
    __device__ __forceinline__ void operator()(const f32x4 (&acc)[2][2][4][2], const Unit& u, int wr, int wc, int fr, int fq) const {
        bf16_t* QR = (bf16_t*)(ws + WS_QR); bf16_t* VR = (bf16_t*)(ws + WS_VR); bf16_t* KF = (bf16_t*)(ws + WS_KF); bf16_t* KBK = (bf16_t*)(ws + WS_KBK); bf16_t* GR = (bf16_t*)(ws + WS_GR);
        float* LFF = (float*)(ws + WS_LFF); float* LFB = (float*)(ws + WS_LFB); const float* LB = (const float*)(ws + WS_LB);
        const int row0 = u.pm * 256 + wr * 64 + fr, typ = u.pn >> 2, colb = (u.pn & 3) * 256 + wc * 32 + 8 * fq;
#pragma unroll
        for (int ai = 0; ai < 2; ++ai)
#pragma unroll
            for (int m = 0; m < 4; ++m)
#pragma unroll
                for (int bj = 0; bj < 2; ++bj) {
                    const size_t off = (size_t)(row0 + ai * 128 + m * 16) * D + colb + bj * 128;
                    float x[8], r[8];
#pragma unroll
                    for (int e = 0; e < 8; ++e) x[e] = acc[ai][bj][m][e >> 2][e & 3];
                    bf16_t* dst;
                    if (typ == 0) { dst = QR;
#pragma unroll
                        for (int e = 0; e < 8; ++e) r[e] = x[e] * fsigmoid(x[e]) * 0.08838834764831845f;
                    } else if (typ == 1) { dst = VR;
#pragma unroll
                        for (int e = 0; e < 8; ++e) r[e] = x[e];
                    } else if (typ == 4) { dst = GR;
#pragma unroll
                        for (int e = 0; e < 8; ++e) r[e] = x[e] * fsigmoid(x[e]);
                    } else {
                        const int dir = typ - 2; dst = dir ? KBK : KF; float* lf = (dir ? LFB : LFF) + off;
                        const float* lbp = LB + dir * 1024 + colb + bj * 128;
                        const f32x4 l0 = *(const f32x4*)lbp, l1 = *(const f32x4*)(lbp + 4);
                        float lg[8];
#pragma unroll
                        for (int e = 0; e < 8; ++e) { const float lb = e < 4 ? l0[e & 3] : l1[e & 3]; const float ez = __expf(-x[e]);
                            const float sg = frcp(1.f + ez), sgn = ez * sg;
                            lg[e] = __logf(lb + (1.f - lb) * sg); r[e] = (1.f - lb) * sgn; }
                        *(f32x4*)lf = (f32x4){lg[0], lg[1], lg[2], lg[3]}; *(f32x4*)(lf + 4) = (f32x4){lg[4], lg[5], lg[6], lg[7]};
                    }
                    u32x4 w; w.x = cvt_pk_bf16(r[0], r[1]); w.y = cvt_pk_bf16(r[2], r[3]); w.z = cvt_pk_bf16(r[4], r[5]); w.w = cvt_pk_bf16(r[6], r[7]);
                    *(u32x4*)(dst + off) = w;
                }
    }
};

__device__ __forceinline__ void transpose_item(const float* W, int K, int N, bf16_t* WT, LAS float* scr, int item, int lane, bool perm) {
    const int nblk = N / 32, kb = item / nblk, nb = item - kb * nblk, k0 = 64 * kb, n0 = 32 * nb;
#pragma unroll 8
    for (int i = 0; i < 32; ++i) { const int kk = 2 * i + (lane >> 5); scr[kk * 33 + (lane & 31)] = W[(size_t)(k0 + kk) * N + n0 + (lane & 31)]; }
    LDSW();
    int row0 = n0;
    if (perm) { const int half = n0 / FF, j0 = n0 - half * FF; row0 = (j0 >> 7) * 256 + half * 128 + (j0 & 127); }
    const int c = lane & 7;
#pragma unroll
    for (int j = 0; j < 4; ++j) { const int n = (lane >> 3) + 8 * j; const LAS float* s = scr + (8 * c) * 33 + n;
        u32x4 o; o.x = cvt_pk_bf16(s[0 * 33], s[1 * 33]); o.y = cvt_pk_bf16(s[2 * 33], s[3 * 33]); o.z = cvt_pk_bf16(s[4 * 33], s[5 * 33]); o.w = cvt_pk_bf16(s[6 * 33], s[7 * 33]);
        *(u32x4*)(WT + (size_t)(row0 + n) * K + k0 + 8 * c) = o; }
    LDSW();
}
__device__ __forceinline__ void ada_item(const float* w_ada, const float* c_ctx, const float* c, float* MODP, int item, int lane) {
    const int l = item / 576, r = item - l * 576, cgp = r >> 4, kc = r & 15;
    const int k = kc * 64 + lane;
    float s0 = c_ctx[k], s1 = c[k], s2 = c[1024 + k];
    s0 = s0 * fsigmoid(s0); s1 = s1 * fsigmoid(s1); s2 = s2 * fsigmoid(s2);
    f32x4 a0 = {0.f, 0.f, 0.f, 0.f}, a1 = a0, a2 = a0;
    const float* wp = w_ada + (size_t)l * 1024 * NADA + (size_t)(kc * 64) * NADA + cgp * 256 + 4 * lane;
#pragma unroll 8
    for (int kk = 0; kk < 64; ++kk) {
        const f32x4 w = *(const f32x4*)(wp + (size_t)kk * NADA);
        const float t0 = __shfl(s0, kk), t1 = __shfl(s1, kk), t2 = __shfl(s2, kk);
        a0 += w * t0; a1 += w * t1; a2 += w * t2;
    }
    float* o = MODP + (size_t)((l * 16 + kc) * 3) * NADA + cgp * 256 + 4 * lane;
    *(f32x4*)o = a0; *(f32x4*)(o + NADA) = a1; *(f32x4*)(o + 2 * NADA) = a2;
}

__device__ __forceinline__ void rw_phase(int G, int bid, int wave, int lane, const float* xp, const float* xs, float* xout, const float* OUTF,
                                         const float* modpost, const float* gpost, float wgt, bool has_post, bool x_from_in,
                                         const float* modpre, const float* gpre, bool has_pre, bf16_t* H) {
    for (int r = bid * 8 + wave; r < MT; r += G * 8) {
        const int grp = r < MP ? 0 : 1 + ((r - MP) >> 10);
        const float* xin = x_from_in ? (r < MP ? xp + (size_t)r * D : xs + (size_t)(r - MP) * D) : xout + (size_t)r * D;
        f32x4 x[4];
#pragma unroll
        for (int j = 0; j < 4; ++j) x[j] = *(const f32x4*)(xin + 4 * lane + 256 * j);
        if (has_post) {
            f32x4 o[4]; float ss = 0.f;
#pragma unroll
            for (int j = 0; j < 4; ++j) { o[j] = *(const f32x4*)(OUTF + (size_t)r * D + 4 * lane + 256 * j); ss += (o[j].x * o[j].x + o[j].y * o[j].y) + (o[j].z * o[j].z + o[j].w * o[j].w); }
            const float rs = rsqrtf(wave_sum(ss) * (1.f / D) + EPS) * wgt;
            const float* gt = modpost + grp * NADA + 2 * D;
#pragma unroll
            for (int j = 0; j < 4; ++j) { const f32x4 g4 = *(const f32x4*)(gt + 4 * lane + 256 * j), p4 = *(const f32x4*)(gpost + 4 * lane + 256 * j);
                x[j] = x[j] + g4 * (o[j] * rs * p4); *(f32x4*)(xout + (size_t)r * D + 4 * lane + 256 * j) = x[j]; }
        }
        if (has_pre) {
            float ss = 0.f;
#pragma unroll
            for (int j = 0; j < 4; ++j) ss += (x[j].x * x[j].x + x[j].y * x[j].y) + (x[j].z * x[j].z + x[j].w * x[j].w);
            const float rs = rsqrtf(wave_sum(ss) * (1.f / D) + EPS);
            const float* sh = modpre + grp * NADA; const float* sc = sh + D;
#pragma unroll
            for (int j = 0; j < 4; ++j) { const int c = 4 * lane + 256 * j; const f32x4 s4 = *(const f32x4*)(sh + c), c4 = *(const f32x4*)(sc + c), p4 = *(const f32x4*)(gpre + c);
                const f32x4 h = x[j] * rs * p4 * (c4 + 1.f) + s4;
                u32x2 w; w.x = cvt_pk_bf16(h.x, h.y); w.y = cvt_pk_bf16(h.z, h.w); *(u32x2*)(H + (size_t)r * D + c) = w; }
        }
    }
}
__device__ __forceinline__ void comb_phase(int G, int bid, int wave, int lane, const float* OF, const float* OB, const bf16_t* GR, const float* gn, bf16_t* AO) {
    for (int r = bid * 8 + wave; r < MT; r += G * 8) {
#pragma unroll
        for (int j = 0; j < 4; ++j) {
            const int c = 4 * lane + 256 * j; const size_t off = (size_t)r * D + c;
            const f32x4 o = *(const f32x4*)(OF + off) + *(const f32x4*)(OB + off);
            float ss = (o.x * o.x + o.y * o.y) + (o.z * o.z + o.w * o.w);
#pragma unroll
            for (int s = 1; s < 32; s <<= 1) ss += __shfl_xor(ss, s);
            const float rs = rsqrtf(ss * (1.f / 128.f) + EPS);
            const f32x4 g4 = *(const f32x4*)(gn + c); const u32x2 gg = *(const u32x2*)(GR + off);
            const float r0 = o.x * rs * g4.x * bf2f(gg.x & 0xffffu), r1 = o.y * rs * g4.y * bf2f(gg.x >> 16), r2 = o.z * rs * g4.z * bf2f(gg.y & 0xffffu), r3 = o.w * rs * g4.w * bf2f(gg.y >> 16);
            u32x2 w; w.x = cvt_pk_bf16(r0, r1); w.y = cvt_pk_bf16(r2, r3); *(u32x2*)(AO + off) = w;
        }
    }
}

constexpr int AT_KS = 72, AT_VS = 136, AT_VOFF = 128 * AT_KS * 2;
template <bool F32SRC>
__device__ __forceinline__ void attn_load_chunk(LAS unsigned char* lds, const void* Kg, const void* Vg, int tid) {
    LAS bf16_t* Ks = (LAS bf16_t*)lds; LAS bf16_t* Vt = (LAS bf16_t*)(lds + AT_VOFF);
#pragma unroll
    for (int i = 0; i < 2; ++i) {
        const int p = tid + 512 * i, key = p >> 3, c8 = p & 7;
        u32x4 kv, vv;
        if (F32SRC) {
            const float* kp = (const float*)Kg + (size_t)key * 256 + c8 * 8; const float* vp = (const float*)Vg + (size_t)key * 256 + c8 * 8;
            const f32x4 k0 = *(const f32x4*)kp, k1 = *(const f32x4*)(kp + 4), v0 = *(const f32x4*)vp, v1 = *(const f32x4*)(vp + 4);
            kv.x = cvt_pk_bf16(k0.x, k0.y); kv.y = cvt_pk_bf16(k0.z, k0.w); kv.z = cvt_pk_bf16(k1.x, k1.y); kv.w = cvt_pk_bf16(k1.z, k1.w);
            vv.x = cvt_pk_bf16(v0.x, v0.y); vv.y = cvt_pk_bf16(v0.z, v0.w); vv.z = cvt_pk_bf16(v1.x, v1.y); vv.w = cvt_pk_bf16(v1.z, v1.w);
        } else {
            kv = *(const u32x4*)((const bf16_t*)Kg + (size_t)key * 256 + c8 * 8); vv = *(const u32x4*)((const bf16_t*)Vg + (size_t)key * 256 + c8 * 8);
        }
        *(LAS u32x4*)(Ks + key * AT_KS + c8 * 8) = kv;
#pragma unroll
        for (int e = 0; e < 8; ++e) { const unsigned w = vv[e >> 1]; Vt[(c8 * 8 + e) * AT_VS + key] = (bf16_t)((e & 1) ? (w >> 16) : (w & 0xffffu)); }
    }
}
__device__ __forceinline__ void attn_phase(LAS unsigned char* lds, const bf16_t* Q, const bf16_t* KB, const bf16_t* VB, const float* ck, const float* cv, const float* sink,
                                           bf16_t* AO, int G, int bid, int tid, int lane, int wave) {
    const int fr = lane & 15, g = lane >> 4;
    LAS bf16_t* Ks = (LAS bf16_t*)lds; LAS bf16_t* Vt = (LAS bf16_t*)(lds + AT_VOFF);
    for (int u = bid; u < 256 + 1024; u += G) {
        const bool lat = u < 256;
        int b, h, qb, rowq0;
        if (lat) { b = u >> 7; h = (u >> 3) & 15; qb = u & 7; rowq0 = MP + b * 1024 + qb * 128; }
        else { const int v = u - 256; b = v >> 5; h = (v >> 1) & 15; qb = v & 1; rowq0 = b * 256 + qb * 128; }
        const int kvh = h >> 2, qq = 16 * wave + fr, row = rowq0 + qq;
        bf16x8 qf[2];
#pragma unroll
        for (int ks = 0; ks < 2; ++ks) qf[ks] = *(const bf16x8*)(Q + (size_t)row * D + h * 64 + ks * 32 + g * 8);
        float mrun = sink[h], lsum = (g == 0) ? 1.f : 0.f;
        f32x4 o[4];
#pragma unroll
        for (int i = 0; i < 4; ++i) o[i] = (f32x4){0.f, 0.f, 0.f, 0.f};
        const int nch = lat ? 5 : 2;
        for (int ci = 0; ci < nch; ++ci) {
            int mode = 1;
            if (lat && ci < 3) { const int blk = qb - 1 + ci; if (blk < 0 || blk > 7) continue; mode = ci; }
            __syncthreads();
            if (lat && ci >= 3) { const size_t off = (size_t)(b * 256 + (ci - 3) * 128) * 256 + kvh * 64; attn_load_chunk<true>(lds, ck + off, cv + off, tid); }
            else { const int r0 = lat ? MP + b * 1024 + (qb - 1 + ci) * 128 : b * 256 + ci * 128; const size_t off = (size_t)r0 * 256 + kvh * 64; attn_load_chunk<false>(lds, KB + off, VB + off, tid); }
            __syncthreads();
            f32x4 st[8];
#pragma unroll
            for (int kb = 0; kb < 8; ++kb) { st[kb] = (f32x4){0.f, 0.f, 0.f, 0.f};
#pragma unroll
                for (int ks = 0; ks < 2; ++ks) { const bf16x8 A = *(const LAS bf16x8*)(Ks + (kb * 16 + fr) * AT_KS + ks * 32 + g * 8); st[kb] = MFMA16(A, qf[ks], st[kb]); } }
            float cmax = -3.0e38f;
            int qv = qq; asm volatile("" : "+v"(qv));
#pragma unroll
            for (int kb = 0; kb < 8; ++kb)
#pragma unroll
                for (int j = 0; j < 4; ++j) { const int kk = kb * 16 + 4 * g + j; float s = st[kb][j] * 0.125f;
                    if (mode == 0 && kk < qv) s = -1e30f;
                    if (mode == 2 && kk > qv) s = -1e30f;
                    st[kb][j] = s; cmax = fmaxf(cmax, s); }
            cmax = fmaxf(cmax, __shfl_xor(cmax, 16)); cmax = fmaxf(cmax, __shfl_xor(cmax, 32));
            const float mnew = fmaxf(mrun, cmax), alpha = __expf(mrun - mnew);
            mrun = mnew; lsum *= alpha;
#pragma unroll
            for (int i = 0; i < 4; ++i) o[i] = o[i] * alpha;
#pragma unroll
            for (int kb = 0; kb < 8; ++kb)
#pragma unroll
                for (int j = 0; j < 4; ++j) { const float p = __expf(st[kb][j] - mnew); st[kb][j] = p; lsum += p; }
#pragma unroll
            for (int i = 0; i < 4; ++i) {
                const bf16x8 pb = mk8(cvt_pk_bf16(st[2 * i][0], st[2 * i][1]), cvt_pk_bf16(st[2 * i][2], st[2 * i][3]), cvt_pk_bf16(st[2 * i + 1][0], st[2 * i + 1][1]), cvt_pk_bf16(st[2 * i + 1][2], st[2 * i + 1][3]));
#pragma unroll
                for (int dvb = 0; dvb < 4; ++dvb) { const LAS bf16_t* vp = Vt + (dvb * 16 + fr) * AT_VS + i * 32 + 4 * g;
                    const u32x2 lo = *(const LAS u32x2*)vp, hi = *(const LAS u32x2*)(vp + 16);
                    o[dvb] = MFMA16(mk8(lo.x, lo.y, hi.x, hi.y), pb, o[dvb]); }
            }
        }
        lsum += __shfl_xor(lsum, 16); lsum += __shfl_xor(lsum, 32);
        const float inv = 1.f / lsum;
#pragma unroll
        for (int dvb = 0; dvb < 4; ++dvb) { u32x2 w; w.x = cvt_pk_bf16(o[dvb][0] * inv, o[dvb][1] * inv); w.y = cvt_pk_bf16(o[dvb][2] * inv, o[dvb][3] * inv);
            *(u32x2*)(AO + (size_t)row * D + h * 64 + dvb * 16 + 4 * g) = w; }
    }
}

constexpr int RC_QD = 0, RC_KI = 17408, RC_KET = 34816, RC_VT = 53248, RC_ST = 71680, RC_SEG = 106496, RC_DEC = 108544;
__device__ __forceinline__ void rec_phase(LAS unsigned char* lds, const bf16_t* QR, const bf16_t* VR, const bf16_t* KF, const bf16_t* KBK, float* LFF, float* LFB,
                                          const float* state_s, float* new_state, float* odummy, int G, int bid, int tid, int lane, int wave) {
    LAS bf16_t* Qd = (LAS bf16_t*)(lds + RC_QD); LAS bf16_t* Ki = (LAS bf16_t*)(lds + RC_KI); LAS bf16_t* KeT = (LAS bf16_t*)(lds + RC_KET);
    LAS bf16_t* Vt = (LAS bf16_t*)(lds + RC_VT); LAS bf16_t* St = (LAS bf16_t*)(lds + RC_ST);
    LAS float* SEG = (LAS float*)(lds + RC_SEG); LAS float* DEC = (LAS float*)(lds + RC_DEC);
    const int fr = lane & 15, g = lane >> 4, cb = wave & 3, vh = wave >> 2;
    const int kcol = tid & 127, seg = tid >> 7;
    int it, step;
    if (G >= 64) { if (bid < 32) { it = bid; step = 1 << 20; } else { it = bid; step = G - 32; } } else { it = bid; step = G; }
    for (; it < 544; it += step) {
        const bool samp = it < 32;
        int b, h, dir, T, rowbase;
        if (samp) { b = it >> 4; h = (it >> 1) & 7; dir = it & 1; T = 1024; rowbase = MP + b * 1024; }
        else { const int p = it - 32; b = p >> 4; h = (p >> 1) & 7; dir = p & 1; T = 256; rowbase = b * 256; }
        float* LFO = dir ? LFB : LFF; const bf16_t* KK = dir ? KBK : KF;
        const int col0 = h * 128;
        f32x4 S[8];
        if (samp) { const float* sp = state_s + (size_t)((b * 2 + dir) * 8 + h) * 16384;
#pragma unroll
            for (int vb = 0; vb < 8; ++vb)
#pragma unroll
                for (int j = 0; j < 4; ++j) S[vb][j] = sp[(wave * 16 + 4 * g + j) * 128 + vb * 16 + fr];
        } else {
#pragma unroll
            for (int vb = 0; vb < 8; ++vb) S[vb] = (f32x4){0.f, 0.f, 0.f, 0.f};
        }
        __syncthreads();
#pragma unroll
        for (int vb = 0; vb < 8; ++vb) { u32x2 w; w.x = cvt_pk_bf16(S[vb][0], S[vb][1]); w.y = cvt_pk_bf16(S[vb][2], S[vb][3]); *(LAS u32x2*)(St + (vb * 16 + fr) * 136 + wave * 16 + 4 * g) = w; }
        const int nchunk = T >> 6;
        for (int n = 0; n < nchunk; ++n) {
            const int s0 = seg * 16;
            const long rstep = dir ? -(long)D : (long)D;
            const size_t base = (size_t)(rowbase + (dir ? T - 1 - (64 * n + s0) : 64 * n + s0)) * D + col0 + kcol;
            float lf[16]; unsigned short qv[16], kv[16], vv[16];
#pragma unroll
            for (int i = 0; i < 16; ++i) lf[i] = LFO[(long)base + rstep * i];
#pragma unroll
            for (int i = 0; i < 16; ++i) { qv[i] = QR[(long)base + rstep * i]; kv[i] = KK[(long)base + rstep * i]; vv[i] = VR[(long)base + rstep * i]; }
#pragma unroll
            for (int i = 1; i < 16; ++i) lf[i] += lf[i - 1];
            SEG[seg * 128 + kcol] = lf[15];
            __syncthreads();
            const float t0 = SEG[kcol], t1 = SEG[128 + kcol], t2 = SEG[256 + kcol], t3 = SEG[384 + kcol];
            const float prefix = (seg > 0 ? t0 : 0.f) + (seg > 1 ? t1 : 0.f) + (seg > 2 ? t2 : 0.f), total = (t0 + t1) + (t2 + t3);
            float ke[16];
#pragma unroll
            for (int i = 0; i < 16; ++i) {
                const float bc = prefix + lf[i], q = bf2f(qv[i]), k = bf2f(kv[i]);
                const float qd = q * __expf(bc), ki = k * __expf(-bc); ke[i] = k * __expf(total - bc);
                const unsigned pk = cvt_pk_bf16(qd, ki);
                Qd[(s0 + i) * 136 + kcol] = (bf16_t)(pk & 0xffffu); Ki[(s0 + i) * 136 + kcol] = (bf16_t)(pk >> 16);
            }
            {
                u32x4 w0, w1;
                w0.x = cvt_pk_bf16(ke[0], ke[1]); w0.y = cvt_pk_bf16(ke[2], ke[3]); w0.z = cvt_pk_bf16(ke[4], ke[5]); w0.w = cvt_pk_bf16(ke[6], ke[7]);
                w1.x = cvt_pk_bf16(ke[8], ke[9]); w1.y = cvt_pk_bf16(ke[10], ke[11]); w1.z = cvt_pk_bf16(ke[12], ke[13]); w1.w = cvt_pk_bf16(ke[14], ke[15]);
                *(LAS u32x4*)(KeT + kcol * 72 + s0) = w0; *(LAS u32x4*)(KeT + kcol * 72 + s0 + 8) = w1;
                u32x4 x0, x1;
                x0.x = (unsigned)vv[0] | ((unsigned)vv[1] << 16); x0.y = (unsigned)vv[2] | ((unsigned)vv[3] << 16); x0.z = (unsigned)vv[4] | ((unsigned)vv[5] << 16); x0.w = (unsigned)vv[6] | ((unsigned)vv[7] << 16);
                x1.x = (unsigned)vv[8] | ((unsigned)vv[9] << 16); x1.y = (unsigned)vv[10] | ((unsigned)vv[11] << 16); x1.z = (unsigned)vv[12] | ((unsigned)vv[13] << 16); x1.w = (unsigned)vv[14] | ((unsigned)vv[15] << 16);
                *(LAS u32x4*)(Vt + kcol * 72 + s0) = x0; *(LAS u32x4*)(Vt + kcol * 72 + s0 + 8) = x1;
            }
            if (seg == 0) DEC[kcol] = __expf(total);
            __syncthreads();
            bf16x8 qd[4];
#pragma unroll
            for (int ks = 0; ks < 4; ++ks) qd[ks] = *(const LAS bf16x8*)(Qd + (cb * 16 + fr) * 136 + ks * 32 + g * 8);
            f32x4 at[4];
            int cv = cb * 16 + fr - 4 * g; asm volatile("" : "+v"(cv));
#pragma unroll
            for (int sb = 0; sb < 4; ++sb) { at[sb] = (f32x4){0.f, 0.f, 0.f, 0.f};
#pragma unroll
                for (int ks = 0; ks < 4; ++ks) { const bf16x8 A = *(const LAS bf16x8*)(Ki + (sb * 16 + fr) * 136 + ks * 32 + g * 8); at[sb] = MFMA16(A, qd[ks], at[sb]); }
#pragma unroll
                for (int j = 0; j < 4; ++j) if (sb * 16 + j > cv) at[sb][j] = 0.f;
            }
            bf16x8 P[2];
#pragma unroll
            for (int x = 0; x < 2; ++x) P[x] = mk8(cvt_pk_bf16(at[2 * x][0], at[2 * x][1]), cvt_pk_bf16(at[2 * x][2], at[2 * x][3]), cvt_pk_bf16(at[2 * x + 1][0], at[2 * x + 1][1]), cvt_pk_bf16(at[2 * x + 1][2], at[2 * x + 1][3]));
            {
                const int c = cb * 16 + fr; const int t = dir ? T - 1 - (64 * n + c) : 64 * n + c;
                float* orow = (odummy ? odummy : LFO) + (size_t)(rowbase + t) * D + col0;
#pragma unroll
                for (int i = 0; i < 4; ++i) { const int vb = vh * 4 + i; f32x4 acc = {0.f, 0.f, 0.f, 0.f};
#pragma unroll
                    for (int x = 0; x < 2; ++x) { const LAS bf16_t* vp = Vt + (vb * 16 + fr) * 72 + x * 32 + 4 * g; const u32x2 lo = *(const LAS u32x2*)vp, hi = *(const LAS u32x2*)(vp + 16);
                        acc = MFMA16(mk8(lo.x, lo.y, hi.x, hi.y), P[x], acc); }
#pragma unroll
                    for (int ks = 0; ks < 4; ++ks) { const bf16x8 A = *(const LAS bf16x8*)(St + (vb * 16 + fr) * 136 + ks * 32 + g * 8); acc = MFMA16(A, qd[ks], acc); }
                    *(f32x4*)(orow + vb * 16 + 4 * g) = acc; }
            }
            {
                bf16x8 kef[2];
#pragma unroll
                for (int x = 0; x < 2; ++x) kef[x] = *(const LAS bf16x8*)(KeT + (wave * 16 + fr) * 72 + x * 32 + g * 8);
                const f32x4 dc = *(const LAS f32x4*)(DEC + wave * 16 + 4 * g);
#pragma unroll
                for (int vb = 0; vb < 8; ++vb) { f32x4 up = {0.f, 0.f, 0.f, 0.f};
#pragma unroll
                    for (int x = 0; x < 2; ++x) { const bf16x8 B = *(const LAS bf16x8*)(Vt + (vb * 16 + fr) * 72 + x * 32 + g * 8); up = MFMA16(kef[x], B, up); }
                    S[vb] = dc * S[vb] + up; }
            }
            __syncthreads();
#pragma unroll
            for (int vb = 0; vb < 8; ++vb) { u32x2 w; w.x = cvt_pk_bf16(S[vb][0], S[vb][1]); w.y = cvt_pk_bf16(S[vb][2], S[vb][3]); *(LAS u32x2*)(St + (vb * 16 + fr) * 136 + wave * 16 + 4 * g) = w; }
        }
        if (!samp) { float* sp = new_state + (size_t)((b * 2 + dir) * 8 + h) * 16384;
#pragma unroll
            for (int vb = 0; vb < 8; ++vb)
#pragma unroll
                for (int j = 0; j < 4; ++j) sp[(wave * 16 + 4 * g + j) * 128 + vb * 16 + fr] = S[vb][j];
        }
    }
}

#define XB_TMO      128
#define XB_XCNT(j)  (256  + 64 * (j))
#define XB_XSUB(j)  (1280 + 64 * (j))
#define XB_XGEN(j)  (2304 + 64 * (j))
#define XB_TOP      3328
#define XB_TOPGEN   3392
#define XCD_BAR_WORDS 3456
#define XB_SPIN_CAP (1u << 18)

__device__ __forceinline__ unsigned xb_ld(unsigned* p)              { return __hip_atomic_load(p, __ATOMIC_RELAXED, __HIP_MEMORY_SCOPE_AGENT); }
__device__ __forceinline__ unsigned xb_add(unsigned* p, unsigned v) { return __hip_atomic_fetch_add(p, v, __ATOMIC_RELAXED, __HIP_MEMORY_SCOPE_AGENT); }
__device__ __forceinline__ unsigned xb_xcc_id() { return (unsigned)__builtin_amdgcn_s_getreg((3 << 11) | 20) & 0xFu; }
#define XB_SPIN(cond, bar) do { unsigned _sp = 0; while (cond) { __builtin_amdgcn_s_sleep(1); \
    if ((++_sp & 255u) == 0u) { if (xb_ld(&(bar)[XB_TMO])) break; if (_sp > XB_SPIN_CAP) { atomicAdd(&(bar)[XB_TMO], 1u); break; } } } } while (0)

struct XcdBarrier {
    unsigned* bar; unsigned x;
    volatile LAS unsigned* st;
};

__device__ __forceinline__ XcdBarrier xcd_barrier_post(unsigned* bar, volatile LAS unsigned* st) {
    XcdBarrier b; b.bar = bar; b.x = xb_xcc_id(); b.st = st;
    if (threadIdx.x == 0) (void)xb_add(&bar[XB_XCNT(b.x)], 1u);
    return b;
}
__device__ __forceinline__ void xcd_barrier_complete(unsigned* bar, unsigned x, unsigned& nloc, unsigned& nx) {
    const unsigned G = gridDim.x * gridDim.y * gridDim.z;
    unsigned sum, cnt, mine, sp = 0u;
    for (;;) {
        sum = 0u; cnt = 0u; mine = 0u;
#pragma unroll
        for (unsigned j = 0; j < 16; ++j) { const unsigned c = xb_ld(&bar[XB_XCNT(j)]); sum += c; cnt += (c > 0u) ? 1u : 0u; mine = (j == x) ? c : mine; }
        if (sum == G) break;
        __builtin_amdgcn_s_sleep(1);
        if ((++sp & 255u) == 0u) { if (xb_ld(&bar[XB_TMO])) break; if (sp > XB_SPIN_CAP) { atomicAdd(&bar[XB_TMO], 1u); break; } }
    }
    nloc = mine > 0u ? mine : 1u; nx = cnt > 0u ? cnt : 1u;
}

__device__ __forceinline__ void xcd_barrier(const XcdBarrier& b) {
    asm volatile("s_waitcnt vmcnt(0)" ::: "memory");
    __syncthreads();
    if (threadIdx.x == 0) {
        unsigned* bar = b.bar;
        __builtin_amdgcn_s_waitcnt(0);
        unsigned nloc = b.st[0], nx = b.st[1];
        if (nloc == 0u) { xcd_barrier_complete(bar, b.x, nloc, nx); b.st[0] = nloc; b.st[1] = nx; }
        const unsigned old = xb_add(&bar[XB_XSUB(b.x)], 1u);
        const unsigned gen = old / nloc;
        if (old + 1u == (gen + 1u) * nloc) {
            __builtin_amdgcn_fence(__ATOMIC_RELEASE, "agent");
            asm volatile("s_waitcnt vmcnt(0)" ::: "memory");
            const unsigned og = xb_add(&bar[XB_TOP], 1u);
            const unsigned tg = og / nx;
            if (og + 1u == (tg + 1u) * nx) xb_add(&bar[XB_TOPGEN], 1u);
            else XB_SPIN(xb_ld(&bar[XB_TOPGEN]) == tg, bar);
            __builtin_amdgcn_fence(__ATOMIC_ACQUIRE, "agent");
            xb_add(&bar[XB_XGEN(b.x)], 1u);
            asm volatile("s_waitcnt vmcnt(0)" ::: "memory");
        } else {
            XB_SPIN(xb_ld(&bar[XB_XGEN(b.x)]) == gen, bar);
            __builtin_amdgcn_fence(__ATOMIC_ACQUIRE, "agent");
            asm volatile("s_waitcnt vmcnt(0)" ::: "memory");
        }
    }
    __syncthreads();
}

struct Args { const float* in[20]; float* out; unsigned char* ws; int ph_lo, ph_hi; };
typedef const __attribute__((address_space(4))) Args* KArgs;
#define KA() ({ KArgs _p = (KArgs)__builtin_amdgcn_kernarg_segment_ptr(); asm volatile("" : "+s"(_p)); _p; })
__global__ void __launch_bounds__(512, 2) fwd_kernel(Args a_unused) {
    extern __shared__ __attribute__((aligned(16))) unsigned char lds_raw[];
    LAS unsigned char* lds = (LAS unsigned char*)lds_raw;
    cg::grid_group grid = cg::this_grid();
    const int G = gridDim.x, bid = blockIdx.x;
    int lo, hi; { KArgs ka = KA(); lo = ka->ph_lo; hi = ka->ph_hi; }
    XcdBarrier xbar;
    { volatile LAS unsigned* MISC = (volatile LAS unsigned*)(lds + LDS_MISC_OFF);
      if (threadIdx.x < 32) MISC[threadIdx.x] = 0u;
      __syncthreads();
      KArgs ka = KA(); xbar = xcd_barrier_post((unsigned*)(ka->ws + WS_BAR), MISC + 8); }
    int ph = 0;
#define PH_BEGIN if (ph >= lo && ph < hi) { KArgs ka = KA(); unsigned char* ws = ka->ws; (void)ws; int tid = threadIdx.x; asm volatile("" : "+v"(tid)); const int lane = tid & 63, wave = __builtin_amdgcn_readfirstlane(tid >> 6); (void)lane; (void)wave;
#define PH_END   if (ph + 1 < hi) { for (int rep_ = 0; rep_ < REP_SYNC; ++rep_) { if (ph == 0) grid.sync(); else xcd_barrier(xbar); } } } ++ph;

    PH_BEGIN
    {
        LAS float* scr = (LAS float*)(lds + wave * 16384);
        const int gw = bid * 8 + wave, NGW = G * 8;
        constexpr int I_ADA = 1152, I_W1 = 16 * 176, I_W2 = 44 * 32, I_QKV = 16 * 48, I_AO = 16 * 32, I_RI = 16 * 160, I_RO = 16 * 32;
        constexpr int E1 = I_ADA, E2 = E1 + 4 * I_W1, E3 = E2 + 4 * I_W2, E4 = E3 + I_QKV, E5 = E4 + I_AO, E6 = E5 + I_RI, NITEMS = E6 + I_RO;
        for (int rep = 0; rep < REP_P0; ++rep)
        for (int it = gw; it < NITEMS; it += NGW) {
            if (it < E1) { ada_item(ka->in[7], ka->in[6], ka->in[2], (float*)(ws + WS_MODP), it, lane); continue; }
            const float* W; bf16_t* WT; int K, N, item; bool perm = false;
            if (it < E2) { const int r = it - E1, w = r / I_W1; item = r - w * I_W1; W = ka->in[11] + (size_t)w * D * NFF1; WT = (bf16_t*)(ws + WS_W1) + (size_t)w * NFF1 * D; K = D; N = NFF1; perm = true; }
            else if (it < E3) { const int r = it - E2, w = r / I_W2; item = r - w * I_W2; W = ka->in[12] + (size_t)w * FF * D; WT = (bf16_t*)(ws + WS_W2) + (size_t)w * D * FF; K = FF; N = D; }
            else if (it < E4) { item = it - E3; W = ka->in[13]; WT = (bf16_t*)(ws + WS_WQKV); K = D; N = NQKV; }
            else if (it < E5) { item = it - E4; W = ka->in[14]; WT = (bf16_t*)(ws + WS_WAO); K = D; N = D; }
            else if (it < E6) { item = it - E5; W = ka->in[16]; WT = (bf16_t*)(ws + WS_WRI); K = D; N = NREC; }
            else { item = it - E6; W = ka->in[19]; WT = (bf16_t*)(ws + WS_WRO); K = D; N = D; }
            transpose_item(W, K, N, WT, scr, item, lane, perm);
        }
    }
    PH_END
    PH_BEGIN
    {
        const float* b_ada = ka->in[8]; const float* rec_lb = ka->in[17];
        const float* MODP = (const float*)(ws + WS_MODP); float* MOD = (float*)(ws + WS_MOD); float* LB = (float*)(ws + WS_LB);
        const int gt = bid * 512 + tid, NT = G * 512;
        for (int idx = gt; idx < 2 * 3 * NADA; idx += NT) {
            const int l = idx / (3 * NADA), r = idx - l * 3 * NADA, g = r / NADA, n = r - g * NADA;
            float s = b_ada[l * NADA + n];
#pragma unroll
            for (int kc = 0; kc < 16; ++kc) s += MODP[(size_t)((l * 16 + kc) * 3 + g) * NADA + n];
            MOD[idx] = s;
        }
        for (int idx = gt; idx < 2048; idx += NT) { const int dir = idx >> 10, i = idx & 1023; const float l0 = rec_lb[(dir * 2 + 0) * 1024 + i], l1 = rec_lb[(dir * 2 + 1) * 1024 + i]; LB[idx] = frcp(1.f + __expf(l0 - l1)); }
    }
    PH_END
    PH_BEGIN
    rw_phase(G, bid, wave, lane, ka->in[0], ka->in[1], ka->out, (const float*)(ws + WS_OUTF), (const float*)(ws + WS_MOD), ka->in[10], 0.f, false, true, (const float*)(ws + WS_MOD), ka->in[9], true, (bf16_t*)(ws + WS_H));
    PH_END

    for (int l = 0; l < 2; ++l) {
        for (int s = 0; s < 3; ++s) {
            if (s != 1) {
                PH_BEGIN
                { const int f = l * 2 + (s >> 1);
                  pg8::Gemm g{(const bf16_t*)(ws + WS_H), (const bf16_t*)(ws + WS_W1) + (size_t)f * NFF1 * D, MT, NFF1, D}; pg8::StaticOrder S; S.init(MT, NFF1, G, bid); EpiSwiGLU E{(bf16_t*)(ws + WS_ACT)};
                  for (int rep = 0; rep < REP_GEMM; ++rep) pg8::gemm_phase<EpiSwiGLU, pg8::StaticOrder, true, true>(lds, g, S, E); }
                PH_END
            } else if (l == 0) {
                PH_BEGIN
                { pg8::Gemm g{(const bf16_t*)(ws + WS_H), (const bf16_t*)(ws + WS_WQKV), MT, NQKV, D}; pg8::StaticOrder S; S.init(MT, NQKV, G, bid);
                  EpiQKV E{ws, ka->out};
                  for (int rep = 0; rep < REP_GEMM; ++rep) pg8::gemm_phase<EpiQKV, pg8::StaticOrder, true, true>(lds, g, S, E); }
                PH_END
                PH_BEGIN
                for (int rep = 0; rep < REP_MIX; ++rep) attn_phase(lds, (const bf16_t*)(ws + WS_Q), (const bf16_t*)(ws + WS_KB), (const bf16_t*)(ws + WS_VB), ka->in[3], ka->in[4], ka->in[15], (bf16_t*)(ws + WS_AO), G, bid, tid, lane, wave);
                PH_END
            } else {
                PH_BEGIN
                { pg8::Gemm g{(const bf16_t*)(ws + WS_H), (const bf16_t*)(ws + WS_WRI), MT, NREC, D}; pg8::StaticOrder S; S.init(MT, NREC, G, bid);
                  EpiRecIn E{ws};
                  for (int rep = 0; rep < REP_GEMM; ++rep) pg8::gemm_phase<EpiRecIn, pg8::StaticOrder, true, true>(lds, g, S, E); }
                PH_END
                PH_BEGIN
                { float* ns_out = ka->out + (size_t)MT * D + (size_t)2 * MP * 256;
                  for (int rep = 0; rep < REP_MIX; ++rep) rec_phase(lds, (const bf16_t*)(ws + WS_QR), (const bf16_t*)(ws + WS_VR), (const bf16_t*)(ws + WS_KF), (const bf16_t*)(ws + WS_KBK), (float*)(ws + WS_LFF), (float*)(ws + WS_LFB), ka->in[5], ns_out,
                                                                  rep + 1 < REP_MIX ? (float*)(ws + WS_OUTF) : (float*)nullptr, G, bid, tid, lane, wave); }
                PH_END
                PH_BEGIN
                for (int rep = 0; rep < REP_MIX; ++rep) comb_phase(G, bid, wave, lane, (const float*)(ws + WS_LFF), (const float*)(ws + WS_LFB), (const bf16_t*)(ws + WS_GR), ka->in[18], (bf16_t*)(ws + WS_QR));
                PH_END
            }
            PH_BEGIN
            { pg8::StaticOrder S; S.init(MT, D, G, bid); EpiF32 E{(float*)(ws + WS_OUTF)};
              if (s != 1) { pg8::Gemm g{(const bf16_t*)(ws + WS_ACT), (const bf16_t*)(ws + WS_W2) + (size_t)(l * 2 + (s >> 1)) * D * FF, MT, D, FF};
                  for (int rep = 0; rep < REP_GEMM; ++rep) pg8::gemm_phase<EpiF32, pg8::StaticOrder, true, true>(lds, g, S, E); }
              else { pg8::Gemm g{(const bf16_t*)(ws + (l == 0 ? WS_AO : WS_QR)), (const bf16_t*)(ws + (l == 0 ? WS_WAO : WS_WRO)), MT, D, D};
                  for (int rep = 0; rep < REP_GEMM; ++rep) pg8::gemm_phase<EpiF32, pg8::StaticOrder, true, true>(lds, g, S, E); } }
            PH_END
            PH_BEGIN
            {
                const bool last = (l == 1 && s == 2);
                const int nl = last ? 0 : ((s == 2) ? l + 1 : l), ns = (s == 2) ? 0 : s + 1;
                const float* MOD = (const float*)(ws + WS_MOD);
                rw_phase(G, bid, wave, lane, ka->in[0], ka->in[1], ka->out, (const float*)(ws + WS_OUTF), MOD + (size_t)l * 3 * NADA + s * 3 * D, ka->in[10] + (size_t)(l * 3 + s) * D, (s == 1) ? 1.f : 0.5f, true, (l == 0 && s == 0),
                         MOD + (size_t)nl * 3 * NADA + ns * 3 * D, ka->in[9] + (size_t)(nl * 3 + ns) * D, !last, (bf16_t*)(ws + WS_H));
            }
            PH_END
        }
    }
#undef PH_BEGIN
#undef PH_END
}

extern "C" void kernel_launch(void* const* d_in, const int* in_sizes, int n_in, void* d_out, int out_size, void* d_ws, size_t ws_size, hipStream_t stream) {
    static int grid = 0;
    if (grid == 0) {
        int dev = 0, cus = 0, per_cu = 0;
        if (n_in != 20 || ws_size < WS_END) { fprintf(stderr, "kernel_launch: unexpected n_in %d / ws_size %zu (need %zu)\n", n_in, ws_size, (size_t)WS_END); grid = -1; return; }
        if (hipGetDevice(&dev) != hipSuccess || hipDeviceGetAttribute(&cus, hipDeviceAttributeMultiprocessorCount, dev) != hipSuccess) { grid = -1; return; }
        if (hipFuncSetAttribute((const void*)fwd_kernel, hipFuncAttributeMaxDynamicSharedMemorySize, LDS_BYTES) != hipSuccess) { fprintf(stderr, "kernel_launch: hipFuncSetAttribute failed\n"); grid = -1; return; }
        if (hipOccupancyMaxActiveBlocksPerMultiprocessor(&per_cu, (const void*)fwd_kernel, 512, LDS_BYTES) != hipSuccess || per_cu < 1) { fprintf(stderr, "kernel_launch: occupancy query gave %d\n", per_cu); per_cu = 1; }
        (void)hipGetLastError();
        grid = cus * per_cu;
    }
    if (grid < 0) return;
    if (hipMemsetAsync((char*)d_ws + WS_BAR, 0, WS_BAR_BYTES, stream) != hipSuccess) { fprintf(stderr, "kernel_launch: hipMemsetAsync failed\n"); return; }
    Args a{};
    for (int i = 0; i < 20; ++i) a.in[i] = (const float*)d_in[i];
    a.out = (float*)d_out; a.ws = (unsigned char*)d_ws;
#if MK_MULTI
    for (int p = 0; p < NPHASES; ++p) { a.ph_lo = p; a.ph_hi = p + 1; void* args[] = {&a};
        hipError_t e = hipLaunchCooperativeKernel((const void*)fwd_kernel, dim3(grid), dim3(512), args, LDS_BYTES, stream);
        if (e != hipSuccess) { fprintf(stderr, "launch %d failed: %s\n", p, hipGetErrorString(e)); break; } }
#else
    a.ph_lo = 0; a.ph_hi = NPHASES; void* args[] = {&a};
    hipError_t e = hipLaunchCooperativeKernel((const void*)fwd_kernel, dim3(grid), dim3(512), args, LDS_BYTES, stream);
    if (e != hipSuccess) fprintf(stderr, "cooperative launch failed: %s (grid %d)\n", hipGetErrorString(e), grid);
#endif
}
```

```cpp
#include <hip/hip_runtime.h>
#include <hip/hip_cooperative_groups.h>
#include <cstdio>
#include <cstdint>
namespace cg = cooperative_groups;
namespace pg8 {
#define PG8_LAS __attribute__((address_space(3)))
typedef unsigned short bf16_t;
typedef short bf16x8 __attribute__((ext_vector_type(8)));
typedef float f32x4 __attribute__((ext_vector_type(4)));
typedef unsigned u32x4 __attribute__((ext_vector_type(4)));
constexpr int BM = 256, BK = 64, HALF = 128, HTB = HALF * BK * 2  , STAGE_BYTES = 8 * HTB, NXCD = 8, WGM = 8;

__host__ __device__ __forceinline__ int lds_byte(int r, int c) { const int st = (r >> 4) * 2 + (c >> 5), rr = r & 15, cc = c & 31, ob = rr * 64 + cc * 2; return st * 1024 + (ob ^ (((ob >> 9) & 1) << 5)); }
__host__ __device__ __forceinline__ void stage_rc(int b, int& R, int& C) { const int st = b / 1024, sb = b % 1024, swz = sb ^ (((sb >> 9) & 1) << 5); R = (st >> 1) * 16 + swz / 64; C = (st & 1) * 32 + (swz % 64) / 2; }
__host__ __device__ __forceinline__ int perm32(int rho) { const int n = rho >> 4, i = rho & 15; return 8 * (i >> 2) + 4 * n + (i & 3); }

struct Unit { int pm, pn; };
struct Gemm { const bf16_t* A; const bf16_t* Bt; int M, N, K; };

struct StaticOrder {
    int nM, nN, nwg, G, c;
    __host__ __device__ void init(int M, int N, int G_, int c_) { nM = M / BM; nN = N / BM; nwg = nM * nN; G = G_; c = c_; }
    __host__ __device__ bool next(int i, Unit& u) const {
        const long L = (long)i * G + c; if (L >= nwg) return false;
        int wgid = (int)L; { const int q = nwg / NXCD, r = nwg % NXCD, xcd = wgid % NXCD, off = wgid / NXCD; wgid = (xcd < r ? xcd * (q + 1) : r * (q + 1) + (xcd - r) * q) + off; }
        const int nig = WGM * nN, gid = wgid / nig, fm = gid * WGM, gsz = (nM - fm) < WGM ? (nM - fm) : WGM;
        u.pm = fm + ((wgid % nig) % gsz); u.pn = (wgid % nig) / gsz; return true;
    }
    __device__ __forceinline__ void a_ready(const Unit&) const {}
    __device__ __forceinline__ void done(const Unit&) const {}
};

__device__ __forceinline__ unsigned cvt_pk_bf16(float lo, float hi) { unsigned r; asm volatile("v_cvt_pk_bf16_f32 %0, %1, %2" : "=v"(r) : "v"(lo), "v"(hi)); return r; }
template <class Epi, class Sched, bool ALIGN_EPI = false, bool SP2 = false>
__device__ __forceinline__ void gemm_phase(PG8_LAS unsigned char* lds, const Gemm g, const Sched& S, const Epi& E) {
    int tid_l = threadIdx.x; asm volatile("" : "+v"(tid_l));
    const int tid = tid_l, wid = __builtin_amdgcn_readfirstlane(tid >> 6), lane = tid & 63, wr = wid >> 2, wc = wid & 3, fr = lane & 15, fq = lane >> 4;
    const int K = g.K, nt = K / BK;
    unsigned voffA[2], voffB[2];
#pragma unroll
    for (int i = 0; i < 2; ++i) { int R, C; stage_rc(tid * 16 + i * 8192, R, C); const int Rb = Epi::PERM ? ((R & ~31) + perm32(R & 31)) : R;
        voffA[i] = (unsigned)(R * K + C) * 2u; voffB[i] = (unsigned)(Rb * K + C) * 2u; }
    const size_t kstep = (size_t)(BK * 2);
    const size_t hstep = (size_t)HALF * K * 2;
    const size_t tstep = 2 * hstep;
    const unsigned ldsw = (unsigned)wid * 1024u;
    const int aoff = lds_byte(wr * 64 + fr, fq * 8), boff = lds_byte(wc * 32 + fr, fq * 8);
#define PG8_SA(b, h) (((b) * 2 + (h)) * HTB)
#define PG8_SB(b, h) ((4 + (b) * 2 + (h)) * HTB)
#define PG8_STAGE(bufoff, gbase, voff) do { _Pragma("unroll") for (int _i = 0; _i < 2; ++_i) \
        __builtin_amdgcn_global_load_lds((const unsigned*)((const char*)(gbase) + (voff)[_i]), (PG8_LAS unsigned*)(lds + (bufoff) + ldsw + _i * 8192), 16, 0, 0); } while (0)
#define PG8_LDA(dst, b, h) do { _Pragma("unroll") for (int m = 0; m < 4; ++m) _Pragma("unroll") for (int k = 0; k < 2; ++k) dst[m][k] = *(const PG8_LAS bf16x8*)(lds + PG8_SA(b, h) + aoff + m * 2048 + k * 1024); } while (0)
#define PG8_LDB(dst, b, h) do { _Pragma("unroll") for (int n = 0; n < 2; ++n) _Pragma("unroll") for (int k = 0; k < 2; ++k) dst[n][k] = *(const PG8_LAS bf16x8*)(lds + PG8_SB(b, h) + boff + n * 2048 + k * 1024); } while (0)
#define PG8_MMA(ai, bj, At, Bt) do { __builtin_amdgcn_s_setprio(1); _Pragma("unroll") for (int m = 0; m < 4; ++m) _Pragma("unroll") for (int n = 0; n < 2; ++n) _Pragma("unroll") for (int k = 0; k < 2; ++k) \
        acc[ai][bj][m][n] = __builtin_amdgcn_mfma_f32_16x16x32_bf16(Bt[n][k], At[m][k], acc[ai][bj][m][n], 0, 0, 0); __builtin_amdgcn_s_setprio(0); } while (0)
#define PG8_WAIT_V(n) asm volatile("s_waitcnt vmcnt(" #n ")" ::: "memory")
#define PG8_WAIT_L(n) asm volatile("s_waitcnt lgkmcnt(" #n ")" ::: "memory")
#define PG8_BAR __builtin_amdgcn_s_barrier()
#define PG8_SCHED __builtin_amdgcn_sched_barrier(0)
    Unit cur, nxt; int ui = 0;
    if (!S.next(0, cur)) return;
    f32x4 acc[2][2][4][2];
#pragma unroll
    for (int a = 0; a < 2; ++a)
#pragma unroll
        for (int b = 0; b < 2; ++b)
#pragma unroll
            for (int m = 0; m < 4; ++m)
#pragma unroll
                for (int n = 0; n < 2; ++n) acc[a][b][m][n] = (f32x4){0.f, 0.f, 0.f, 0.f};
    bf16x8 At[4][2], B0[2][2], B1[2][2];
    const char* cA = (const char*)g.A + (size_t)cur.pm * tstep; const char* cB = (const char*)g.Bt + (size_t)cur.pn * tstep;
    S.a_ready(cur);
    if constexpr (SP2) {
        PG8_STAGE(PG8_SB(0, 0), cB, voffB); PG8_STAGE(PG8_SB(0, 1), cB + hstep, voffB); PG8_STAGE(PG8_SA(0, 0), cA, voffA); PG8_STAGE(PG8_SA(0, 1), cA + hstep, voffA);
        if (wr == 1) PG8_BAR;
        PG8_WAIT_V(2); PG8_BAR;
        PG8_STAGE(PG8_SB(1, 0), cB + kstep, voffB); PG8_STAGE(PG8_SA(1, 0), cA + kstep, voffA); PG8_STAGE(PG8_SB(1, 1), cB + hstep + kstep, voffB);
        PG8_WAIT_V(6); PG8_BAR;
    } else {
        PG8_STAGE(PG8_SB(0, 0), cB, voffB); PG8_STAGE(PG8_SA(0, 0), cA, voffA); PG8_STAGE(PG8_SB(0, 1), cB + hstep, voffB); PG8_STAGE(PG8_SA(0, 1), cA + hstep, voffA);
        if (wr == 1) PG8_BAR;
        PG8_WAIT_V(4); PG8_BAR;
        PG8_STAGE(PG8_SB(1, 0), cB + kstep, voffB); PG8_STAGE(PG8_SA(1, 0), cA + kstep, voffA); PG8_STAGE(PG8_SB(1, 1), cB + hstep + kstep, voffB);
        PG8_WAIT_V(6); PG8_BAR;
    }
    for (;;) {
        const bool has_next = S.next(ui + 1, nxt);
        const char* nA = has_next ? (const char*)g.A + (size_t)nxt.pm * tstep : cA; const char* nB = has_next ? (const char*)g.Bt + (size_t)nxt.pn * tstep : cB;
        for (int t = 0; t < nt; t += 2) {
            const bool last = (t == nt - 2);
            const char* a1 = cA + (size_t)(t + 1) * kstep;
            const char* a2 = last ? nA : cA + (size_t)(t + 2) * kstep; const char* b2 = last ? nB : cB + (size_t)(t + 2) * kstep;
            const char* a3 = a2 + kstep; const char* b3 = b2 + kstep;
            if (last && has_next) S.a_ready(nxt);
            if constexpr (SP2) {
            PG8_LDB(B0, 0, 0); PG8_LDB(B1, 0, 1); PG8_SCHED; PG8_LDA(At, 0, 0); PG8_STAGE(PG8_SA(1, 1), a1 + hstep, voffA);
            PG8_WAIT_V(8); PG8_WAIT_L(0); PG8_BAR; PG8_MMA(0, 0, At, B0); PG8_MMA(0, 1, At, B1); PG8_BAR; PG8_SCHED;
            PG8_LDA(At, 0, 1); PG8_STAGE(PG8_SB(0, 0), b2, voffB); PG8_STAGE(PG8_SB(0, 1), b2 + hstep, voffB); PG8_STAGE(PG8_SA(0, 0), a2, voffA);
            PG8_WAIT_V(8); PG8_WAIT_L(0); PG8_BAR; PG8_MMA(1, 0, At, B0); PG8_MMA(1, 1, At, B1); PG8_BAR; PG8_SCHED;
            PG8_LDB(B0, 1, 0); PG8_LDB(B1, 1, 1); PG8_SCHED; PG8_LDA(At, 1, 0); PG8_STAGE(PG8_SA(0, 1), a2 + hstep, voffA);
            PG8_WAIT_V(8); PG8_WAIT_L(0); PG8_BAR; PG8_MMA(0, 0, At, B0); PG8_MMA(0, 1, At, B1); PG8_BAR; PG8_SCHED;
            PG8_LDA(At, 1, 1); PG8_STAGE(PG8_SB(1, 0), b3, voffB); PG8_STAGE(PG8_SB(1, 1), b3 + hstep, voffB); PG8_STAGE(PG8_SA(1, 0), a3, voffA);
            PG8_WAIT_V(8); PG8_WAIT_L(0); PG8_BAR; PG8_MMA(1, 0, At, B0); PG8_MMA(1, 1, At, B1); PG8_BAR; PG8_SCHED;
            } else {
            PG8_LDB(B0, 0, 0); PG8_SCHED; PG8_LDA(At, 0, 0); PG8_STAGE(PG8_SA(1, 1), a1 + hstep, voffA);
            PG8_WAIT_L(8); PG8_BAR; PG8_WAIT_L(0); PG8_MMA(0, 0, At, B0); PG8_BAR; PG8_SCHED;
            PG8_LDB(B1, 0, 1); PG8_STAGE(PG8_SB(0, 0), b2, voffB);
            PG8_BAR; PG8_WAIT_L(0); PG8_MMA(0, 1, At, B1); PG8_BAR;
            PG8_LDA(At, 0, 1); PG8_STAGE(PG8_SA(0, 0), a2, voffA);
            PG8_BAR; PG8_WAIT_L(0); PG8_MMA(1, 0, At, B0); PG8_BAR; PG8_SCHED;
            PG8_STAGE(PG8_SB(0, 1), b2 + hstep, voffB);
            PG8_WAIT_V(6); PG8_BAR; PG8_MMA(1, 1, At, B1); PG8_BAR;
            PG8_LDB(B0, 1, 0); PG8_SCHED; PG8_LDA(At, 1, 0); PG8_STAGE(PG8_SA(0, 1), a2 + hstep, voffA);
            PG8_WAIT_L(8); PG8_BAR; PG8_WAIT_L(0); PG8_MMA(0, 0, At, B0); PG8_BAR; PG8_SCHED;
            PG8_LDB(B1, 1, 1); PG8_STAGE(PG8_SB(1, 0), b3, voffB);
            PG8_BAR; PG8_WAIT_L(0); PG8_MMA(0, 1, At, B1); PG8_BAR;
            PG8_LDA(At, 1, 1); PG8_STAGE(PG8_SA(1, 0), a3, voffA);
            PG8_BAR; PG8_WAIT_L(0); PG8_MMA(1, 0, At, B0); PG8_BAR; PG8_SCHED;
            PG8_STAGE(PG8_SB(1, 1), b3 + hstep, voffB);
            PG8_WAIT_V(6); PG8_BAR; PG8_MMA(1, 1, At, B1); PG8_BAR;
            }
        }
        if constexpr (ALIGN_EPI) { if (wr == 0) PG8_BAR; }
        if constexpr (!Epi::AFTER_DRAIN) { E(acc, cur, wr, wc, fr, fq); S.done(cur); }
        if (!has_next) break;
#pragma unroll
        for (int a = 0; a < 2; ++a)
#pragma unroll
            for (int b = 0; b < 2; ++b)
#pragma unroll
                for (int m = 0; m < 4; ++m)
#pragma unroll
                    for (int n = 0; n < 2; ++n) acc[a][b][m][n] = (f32x4){0.f, 0.f, 0.f, 0.f};
        cur = nxt; cA = nA; cB = nB; ++ui;
        if constexpr (ALIGN_EPI) { if (wr == 1) PG8_BAR; }
    }
    PG8_WAIT_V(0);
    if constexpr (!ALIGN_EPI) { if (wr == 0) PG8_BAR; }
    PG8_BAR;
    if constexpr (Epi::AFTER_DRAIN) { E.fused(acc, cur, wr, wc, fr, fq, lds, wid, lane); S.done(cur); }
#undef PG8_SA
#undef PG8_SB
#undef PG8_STAGE
#undef PG8_LDA
#undef PG8_LDB
#undef PG8_MMA
#undef PG8_WAIT_V
#undef PG8_WAIT_L
#undef PG8_BAR
#undef PG8_SCHED
}
}

#ifndef MK_MULTI
#define MK_MULTI 0
#endif
#ifndef REP_GEMM
#define REP_GEMM 1
#endif
#ifndef REP_SYNC
#define REP_SYNC 1
#endif
#ifndef REP_P0
#define REP_P0 1
#endif
#ifndef REP_MIX
#define REP_MIX 1
#endif
#define LAS __attribute__((address_space(3)))
typedef unsigned short bf16_t;
typedef short bf16x8 __attribute__((ext_vector_type(8)));
typedef float f32x4 __attribute__((ext_vector_type(4)));
typedef unsigned u32x4 __attribute__((ext_vector_type(4)));
typedef unsigned u32x2 __attribute__((ext_vector_type(2)));
using pg8::cvt_pk_bf16;

constexpr int D = 1024, MP = 8192, MS = 2048, MT = MP + MS, FF = 2816, NFF1 = 2 * FF, NQKV = 1536, NREC = 5120, NADA = 9216;
constexpr float EPS = 1e-6f;
constexpr int LDS_BYTES = 147456;
constexpr int NPHASES = 24;

constexpr size_t MiB = 1u << 20;
constexpr size_t WS_BAR = 0, WS_BAR_BYTES = 16384;
constexpr int LDS_MISC_OFF = 131072 + 320;
constexpr size_t WS_MODP = 1 * MiB;
constexpr size_t WS_MOD = 5 * MiB;
constexpr size_t WS_LB = 6 * MiB;
constexpr size_t WS_W1 = 8 * MiB;
constexpr size_t WS_W2 = 52 * MiB;
constexpr size_t WS_WQKV = 74 * MiB, WS_WAO = 77 * MiB, WS_WRI = 79 * MiB, WS_WRO = 89 * MiB;
constexpr size_t WS_H = 91 * MiB;
constexpr size_t WS_OUTF = 111 * MiB;
constexpr size_t WS_BIG = 151 * MiB;
constexpr size_t WS_ACT = WS_BIG;
constexpr size_t WS_Q = WS_BIG, WS_KB = WS_BIG + 20 * MiB, WS_VB = WS_BIG + 25 * MiB, WS_AO = WS_BIG + 30 * MiB;
constexpr size_t WS_QR = WS_BIG, WS_VR = WS_BIG + 20 * MiB, WS_KF = WS_BIG + 40 * MiB, WS_KBK = WS_BIG + 60 * MiB, WS_GR = WS_BIG + 80 * MiB;
constexpr size_t WS_LFF = WS_BIG + 100 * MiB, WS_LFB = WS_BIG + 140 * MiB;
constexpr size_t WS_END = WS_BIG + 180 * MiB;

__device__ __forceinline__ float bf2f(unsigned u16) { return __builtin_bit_cast(float, u16 << 16); }
__device__ __forceinline__ float wave_sum(float v) {
#pragma unroll
    for (int o = 1; o < 64; o <<= 1) v += __shfl_xor(v, o);
    return v;
}
__device__ __forceinline__ float frcp(float x) { return __builtin_amdgcn_rcpf(x); }
__device__ __forceinline__ float fsigmoid(float x) { return frcp(1.f + __expf(-x)); }
__device__ __forceinline__ bf16x8 mk8(unsigned a, unsigned b, unsigned c, unsigned d) { u32x4 t = {a, b, c, d}; return __builtin_bit_cast(bf16x8, t); }
#define MFMA16(a, b, c) __builtin_amdgcn_mfma_f32_16x16x32_bf16((a), (b), (c), 0, 0, 0)
#define LDSW() asm volatile("s_waitcnt lgkmcnt(0)" ::: "memory")

using pg8::Unit;
struct EpiSwiGLU {
    static constexpr bool PERM = true, AFTER_DRAIN = false;
    bf16_t* O;
    __device__ __forceinline__ void operator()(const f32x4 (&acc)[2][2][4][2], const Unit& u, int wr, int wc, int fr, int fq) const {
        const int row0 = u.pm * 256 + wr * 64 + fr, col0 = u.pn * 128 + wc * 32 + 8 * fq;
#pragma unroll
        for (int ai = 0; ai < 2; ++ai)
#pragma unroll
            for (int m = 0; m < 4; ++m) {
                bf16_t* p = O + (size_t)(row0 + ai * 128 + m * 16) * FF + col0;
                float r[8];
#pragma unroll
                for (int n = 0; n < 2; ++n)
#pragma unroll
                    for (int j = 0; j < 4; ++j) { const float av = acc[ai][0][m][n][j], bv = acc[ai][1][m][n][j]; r[n * 4 + j] = av * bv * fsigmoid(av); }
                u32x4 w; w.x = cvt_pk_bf16(r[0], r[1]); w.y = cvt_pk_bf16(r[2], r[3]); w.z = cvt_pk_bf16(r[4], r[5]); w.w = cvt_pk_bf16(r[6], r[7]);
                *(u32x4*)p = w;
            }
    }
};
struct EpiF32 {
    static constexpr bool PERM = true, AFTER_DRAIN = false;
    float* O;
    __device__ __forceinline__ void operator()(const f32x4 (&acc)[2][2][4][2], const Unit& u, int wr, int wc, int fr, int fq) const {
        const int row0 = u.pm * 256 + wr * 64 + fr, col0 = u.pn * 256 + wc * 32 + 8 * fq;
#pragma unroll
        for (int ai = 0; ai < 2; ++ai)
#pragma unroll
            for (int m = 0; m < 4; ++m)
#pragma unroll
                for (int bj = 0; bj < 2; ++bj) {
                    float* p = O + (size_t)(row0 + ai * 128 + m * 16) * D + col0 + bj * 128;
                    *(f32x4*)p = acc[ai][bj][m][0]; *(f32x4*)(p + 4) = acc[ai][bj][m][1];
                }
    }
};
struct EpiQKV {
    static constexpr bool PERM = false, AFTER_DRAIN = false;
    unsigned char* ws; float* out;
    __device__ __forceinline__ void operator()(const f32x4 (&acc)[2][2][4][2], const Unit& u, int wr, int wc, int fr, int fq) const {
        bf16_t* Q = (bf16_t*)(ws + WS_Q); bf16_t* KB = (bf16_t*)(ws + WS_KB); bf16_t* VB = (bf16_t*)(ws + WS_VB); float* ck_out = out + (size_t)MT * D; float* cv_out = ck_out + (size_t)MP * 256;
        const int row0 = u.pm * 256 + wr * 64 + fr;
        const bool samp = u.pm >= 32, rope = samp && (u.pn <= 4);
        float inv[4];
#pragma unroll
        for (int j = 0; j < 4; ++j) inv[j] = exp2f(-(float)(4 * fq + j) * (13.287712379549449f / 16.f));
#pragma unroll
        for (int ai = 0; ai < 2; ++ai)
#pragma unroll
            for (int m = 0; m < 4; ++m) {
                const int r = row0 + ai * 128 + m * 16;
                float cs[4], sn[4];
                if (rope) {
                    const int t = (r - MP) & 1023; const float pos = (float)((wc & 1) ? (t & 63) : (t >> 6));
#pragma unroll
                    for (int j = 0; j < 4; ++j) { const float ang = pos * inv[j]; cs[j] = __cosf(ang); sn[j] = __sinf(ang); }
                }
#pragma unroll
                for (int bj = 0; bj < 2; ++bj) {
                    f32x4 v0 = acc[ai][bj][m][0], v1 = acc[ai][bj][m][1];
                    if (rope) {
#pragma unroll
                        for (int j = 0; j < 4; ++j) { const float x1 = v0[j], x2 = v1[j]; v0[j] = x1 * cs[j] - x2 * sn[j]; v1[j] = x1 * sn[j] + x2 * cs[j]; }
                    }
                    const int cc = 128 * bj + 32 * wc + 4 * fq;
                    u32x2 w0, w1; w0.x = cvt_pk_bf16(v0[0], v0[1]); w0.y = cvt_pk_bf16(v0[2], v0[3]); w1.x = cvt_pk_bf16(v1[0], v1[1]); w1.y = cvt_pk_bf16(v1[2], v1[3]);
                    if (u.pn < 4) { bf16_t* p = Q + (size_t)r * D + u.pn * 256 + cc; *(u32x2*)p = w0; *(u32x2*)(p + 16) = w1; }
                    else {
                        bf16_t* p = (u.pn == 4 ? KB : VB) + (size_t)r * 256 + cc; *(u32x2*)p = w0; *(u32x2*)(p + 16) = w1;
                        if (!samp) { float* c = (u.pn == 4 ? ck_out : cv_out) + (size_t)r * 256 + cc; *(f32x4*)c = v0; *(f32x4*)(c + 16) = v1; }
                    }
                }
            }
    }
};
struct EpiRecIn {
    static constexpr bool PERM = true, AFTER_DRAIN = false;
    unsigned char* ws;
    __device__ __forceinline__ void operator()(const f32x4 (&acc)[2][2][4][2], const Unit& u, int wr, int wc, int fr, int fq) const {
        bf16_t* QR = (bf16_t*)(ws + WS_QR); bf16_t* VR = (bf16_t*)(ws + WS_VR); bf16_t* KF = (bf16_t*)(ws + WS_KF); bf16_t* KBK = (bf16_t*)(ws + WS_KBK); bf16_t* GR = (bf16_t*)(ws + WS_GR);
        float* LFF = (float*)(ws + WS_LFF); float* LFB = (float*)(ws + WS_LFB); const float* LB = (const float*)(ws + WS_LB);
        const int row0 = u.pm * 256 + wr * 64 + fr, typ = u.pn >> 2, colb = (u.pn & 3) * 256 + wc * 32 + 8 * fq;
#pragma unroll
        for (int ai = 0; ai < 2; ++ai)
#pragma unroll
            for (int m = 0; m < 4; ++m)
#pragma unroll
                for (int bj = 0; bj < 2; ++bj) {
                    const size_t off = (size_t)(row0 + ai * 128 + m * 16) * D + colb + bj * 128;
                    float x[8], r[8];
#pragma unroll
                    for (int e = 0; e < 8; ++e) x[e] = acc[ai][bj][m][e >> 2][e & 3];
                    bf16_t* dst;
                    if (typ == 0) { dst = QR;
#pragma unroll
                        for (int e = 0; e < 8; ++e) r[e] = x[e] * fsigmoid(x[e]) * 0.08838834764831845f;
                    } else if (typ == 1) { dst = VR;
#pragma unroll
                        for (int e = 0; e < 8; ++e) r[e] = x[e];
                    } else if (typ == 4) { dst = GR;
#pragma unroll
                        for (int e = 0; e < 8; ++e) r[e] = x[e] * fsigmoid(x[e]);
                    } else {
                        const int dir = typ - 2; dst = dir ? KBK : KF; float* lf = (dir ? LFB : LFF) + off;
                        const float* lbp = LB + dir * 1024 + colb + bj * 128;
                        const f32x4 l0 = *(const f32x4*)lbp, l1 = *(const f32x4*)(lbp + 4);
                        float lg[8];
#pragma unroll
                        for (int e = 0; e < 8; ++e) { const float lb = e < 4 ? l0[e & 3] : l1[e & 3]; const float ez = __expf(-x[e]);
                            const float sg = frcp(1.f + ez), sgn = ez * sg;
                            lg[e] = __logf(lb + (1.f - lb) * sg); r[e] = (1.f - lb) * sgn; }
                        *(f32x4*)lf = (f32x4){lg[0], lg[1], lg[2], lg[3]}; *(f32x4*)(lf + 4) = (f32x4){lg[4], lg[5], lg[6], lg[7]};
                    }
                    u32x4 w; w.x = cvt_pk_bf16(r[0], r[1]); w.y = cvt_pk_bf16(r[2], r[3]); w.z = cvt_pk_bf16(r[4], r[5]); w.w = cvt_pk_bf16(r[6], r[7]);
                    *(u32x4*)(dst + off) = w;
                }
    }
};

__device__ __forceinline__ void transpose_item(const float* W, int K, int N, bf16_t* WT, LAS float* scr, int item, int lane, bool perm) {
    const int nblk = N / 32, kb = item / nblk, nb = item - kb * nblk, k0 = 64 * kb, n0 = 32 * nb;
#pragma unroll 8
    for (int i = 0; i < 32; ++i) { const int kk = 2 * i + (lane >> 5); scr[kk * 33 + (lane & 31)] = W[(size_t)(k0 + kk) * N + n0 + (lane & 31)]; }
    LDSW();
    int row0 = n0;
    if (perm) { const int half = n0 / FF, j0 = n0 - half * FF; row0 = (j0 >> 7) * 256 + half * 128 + (j0 & 127); }
    const int c = lane & 7;
#pragma unroll
    for (int j = 0; j < 4; ++j) { const int n = (lane >> 3) + 8 * j; const LAS float* s = scr + (8 * c) * 33 + n;
        u32x4 o; o.x = cvt_pk_bf16(s[0 * 33], s[1 * 33]); o.y = cvt_pk_bf16(s[2 * 33], s[3 * 33]); o.z = cvt_pk_bf16(s[4 * 33], s[5 * 33]); o.w = cvt_pk_bf16(s[6 * 33], s[7 * 33]);
        *(u32x4*)(WT + (size_t)(row0 + n) * K + k0 + 8 * c) = o; }
    LDSW();
}
__device__ __forceinline__ void ada_item(const float* w_ada, const float* c_ctx, const float* c, float* MODP, int item, int lane) {
    const int l = item / 576, r = item - l * 576, cgp = r >> 4, kc = r & 15;
    const int k = kc * 64 + lane;
    float s0 = c_ctx[k], s1 = c[k], s2 = c[1024 + k];
    s0 = s0 * fsigmoid(s0); s1 = s1 * fsigmoid(s1); s2 = s2 * fsigmoid(s2);
    f32x4 a0 = {0.f, 0.f, 0.f, 0.f}, a1 = a0, a2 = a0;
    const float* wp = w_ada + (size_t)l * 1024 * NADA + (size_t)(kc * 64) * NADA + cgp * 256 + 4 * lane;
#pragma unroll 8
    for (int kk = 0; kk < 64; ++kk) {
        const f32x4 w = *(const f32x4*)(wp + (size_t)kk * NADA);
        const float t0 = __shfl(s0, kk), t1 = __shfl(s1, kk), t2 = __shfl(s2, kk);
        a0 += w * t0; a1 += w * t1; a2 += w * t2;
    }
    float* o = MODP + (size_t)((l * 16 + kc) * 3) * NADA + cgp * 256 + 4 * lane;
    *(f32x4*)o = a0; *(f32x4*)(o + NADA) = a1; *(f32x4*)(o + 2 * NADA) = a2;
}

__device__ __forceinline__ void rw_phase(int G, int bid, int wave, int lane, const float* xp, const float* xs, float* xout, const float* OUTF,
                                         const float* modpost, const float* gpost, float wgt, bool has_post, bool x_from_in,
                                         const float* modpre, const float* gpre, bool has_pre, bf16_t* H) {
    for (int r = bid * 8 + wave; r < MT; r += G * 8) {
        const int grp = r < MP ? 0 : 1 + ((r - MP) >> 10);
        const float* xin = x_from_in ? (r < MP ? xp + (size_t)r * D : xs + (size_t)(r - MP) * D) : xout + (size_t)r * D;
        f32x4 x[4];
#pragma unroll
        for (int j = 0; j < 4; ++j) x[j] = *(const f32x4*)(xin + 4 * lane + 256 * j);
        if (has_post) {
            f32x4 o[4]; float ss = 0.f;
#pragma unroll
            for (int j = 0; j < 4; ++j) { o[j] = *(const f32x4*)(OUTF + (size_t)r * D + 4 * lane + 256 * j); ss += (o[j].x * o[j].x + o[j].y * o[j].y) + (o[j].z * o[j].z + o[j].w * o[j].w); }
            const float rs = rsqrtf(wave_sum(ss) * (1.f / D) + EPS) * wgt;
            const float* gt = modpost + grp * NADA + 2 * D;
#pragma unroll
            for (int j = 0; j < 4; ++j) { const f32x4 g4 = *(const f32x4*)(gt + 4 * lane + 256 * j), p4 = *(const f32x4*)(gpost + 4 * lane + 256 * j);
                x[j] = x[j] + g4 * (o[j] * rs * p4); *(f32x4*)(xout + (size_t)r * D + 4 * lane + 256 * j) = x[j]; }
        }
        if (has_pre) {
            float ss = 0.f;
#pragma unroll
            for (int j = 0; j < 4; ++j) ss += (x[j].x * x[j].x + x[j].y * x[j].y) + (x[j].z * x[j].z + x[j].w * x[j].w);
            const float rs = rsqrtf(wave_sum(ss) * (1.f / D) + EPS);
            const float* sh = modpre + grp * NADA; const float* sc = sh + D;
#pragma unroll
            for (int j = 0; j < 4; ++j) { const int c = 4 * lane + 256 * j; const f32x4 s4 = *(const f32x4*)(sh + c), c4 = *(const f32x4*)(sc + c), p4 = *(const f32x4*)(gpre + c);
                const f32x4 h = x[j] * rs * p4 * (c4 + 1.f) + s4;
                u32x2 w; w.x = cvt_pk_bf16(h.x, h.y); w.y = cvt_pk_bf16(h.z, h.w); *(u32x2*)(H + (size_t)r * D + c) = w; }
        }
    }
}
__device__ __forceinline__ void comb_phase(int G, int bid, int wave, int lane, const float* OF, const float* OB, const bf16_t* GR, const float* gn, bf16_t* AO) {
    for (int r = bid * 8 + wave; r < MT; r += G * 8) {
#pragma unroll
        for (int j = 0; j < 4; ++j) {
            const int c = 4 * lane + 256 * j; const size_t off = (size_t)r * D + c;
            const f32x4 o = *(const f32x4*)(OF + off) + *(const f32x4*)(OB + off);
            float ss = (o.x * o.x + o.y * o.y) + (o.z * o.z + o.w * o.w);
#pragma unroll
            for (int s = 1; s < 32; s <<= 1) ss += __shfl_xor(ss, s);
            const float rs = rsqrtf(ss * (1.f / 128.f) + EPS);
            const f32x4 g4 = *(const f32x4*)(gn + c); const u32x2 gg = *(const u32x2*)(GR + off);
            const float r0 = o.x * rs * g4.x * bf2f(gg.x & 0xffffu), r1 = o.y * rs * g4.y * bf2f(gg.x >> 16), r2 = o.z * rs * g4.z * bf2f(gg.y & 0xffffu), r3 = o.w * rs * g4.w * bf2f(gg.y >> 16);
            u32x2 w; w.x = cvt_pk_bf16(r0, r1); w.y = cvt_pk_bf16(r2, r3); *(u32x2*)(AO + off) = w;
        }
    }
}

constexpr int AT_KS = 72, AT_VS = 136, AT_VOFF = 128 * AT_KS * 2;
template <bool F32SRC>
__device__ __forceinline__ void attn_load_chunk(LAS unsigned char* lds, const void* Kg, const void* Vg, int tid) {
    LAS bf16_t* Ks = (LAS bf16_t*)lds; LAS bf16_t* Vt = (LAS bf16_t*)(lds + AT_VOFF);
#pragma unroll
    for (int i = 0; i < 2; ++i) {
        const int p = tid + 512 * i, key = p >> 3, c8 = p & 7;
        u32x4 kv, vv;
        if (F32SRC) {
            const float* kp = (const float*)Kg + (size_t)key * 256 + c8 * 8; const float* vp = (const float*)Vg + (size_t)key * 256 + c8 * 8;
            const f32x4 k0 = *(const f32x4*)kp, k1 = *(const f32x4*)(kp + 4), v0 = *(const f32x4*)vp, v1 = *(const f32x4*)(vp + 4);
            kv.x = cvt_pk_bf16(k0.x, k0.y); kv.y = cvt_pk_bf16(k0.z, k0.w); kv.z = cvt_pk_bf16(k1.x, k1.y); kv.w = cvt_pk_bf16(k1.z, k1.w);
            vv.x = cvt_pk_bf16(v0.x, v0.y); vv.y = cvt_pk_bf16(v0.z, v0.w); vv.z = cvt_pk_bf16(v1.x, v1.y); vv.w = cvt_pk_bf16(v1.z, v1.w);
        } else {
            kv = *(const u32x4*)((const bf16_t*)Kg + (size_t)key * 256 + c8 * 8); vv = *(const u32x4*)((const bf16_t*)Vg + (size_t)key * 256 + c8 * 8);
        }
        *(LAS u32x4*)(Ks + key * AT_KS + c8 * 8) = kv;
#pragma unroll
        for (int e = 0; e < 8; ++e) { const unsigned w = vv[e >> 1]; Vt[(c8 * 8 + e) * AT_VS + key] = (bf16_t)((e & 1) ? (w >> 16) : (w & 0xffffu)); }
    }
}
__device__ __forceinline__ void attn_phase(LAS unsigned char* lds, const bf16_t* Q, const bf16_t* KB, const bf16_t* VB, const float* ck, const float* cv, const float* sink,
                                           bf16_t* AO, int G, int bid, int tid, int lane, int wave) {
    const int fr = lane & 15, g = lane >> 4;
    LAS bf16_t* Ks = (LAS bf16_t*)lds; LAS bf16_t* Vt = (LAS bf16_t*)(lds + AT_VOFF);
    for (int u = bid; u < 256 + 1024; u += G) {
        const bool lat = u < 256;
        int b, h, qb, rowq0;
        if (lat) { b = u >> 7; h = (u >> 3) & 15; qb = u & 7; rowq0 = MP + b * 1024 + qb * 128; }
        else { const int v = u - 256; b = v >> 5; h = (v >> 1) & 15; qb = v & 1; rowq0 = b * 256 + qb * 128; }
        const int kvh = h >> 2, qq = 16 * wave + fr, row = rowq0 + qq;
        bf16x8 qf[2];
#pragma unroll
        for (int ks = 0; ks < 2; ++ks) qf[ks] = *(const bf16x8*)(Q + (size_t)row * D + h * 64 + ks * 32 + g * 8);
        float mrun = sink[h], lsum = (g == 0) ? 1.f : 0.f;
        f32x4 o[4];
#pragma unroll
        for (int i = 0; i < 4; ++i) o[i] = (f32x4){0.f, 0.f, 0.f, 0.f};
        const int nch = lat ? 5 : 2;
        for (int ci = 0; ci < nch; ++ci) {
            int mode = 1;
            if (lat && ci < 3) { const int blk = qb - 1 + ci; if (blk < 0 || blk > 7) continue; mode = ci; }
            __syncthreads();
            if (lat && ci >= 3) { const size_t off = (size_t)(b * 256 + (ci - 3) * 128) * 256 + kvh * 64; attn_load_chunk<true>(lds, ck + off, cv + off, tid); }
            else { const int r0 = lat ? MP + b * 1024 + (qb - 1 + ci) * 128 : b * 256 + ci * 128; const size_t off = (size_t)r0 * 256 + kvh * 64; attn_load_chunk<false>(lds, KB + off, VB + off, tid); }
            __syncthreads();
            f32x4 st[8];
#pragma unroll
            for (int kb = 0; kb < 8; ++kb) { st[kb] = (f32x4){0.f, 0.f, 0.f, 0.f};
#pragma unroll
                for (int ks = 0; ks < 2; ++ks) { const bf16x8 A = *(const LAS bf16x8*)(Ks + (kb * 16 + fr) * AT_KS + ks * 32 + g * 8); st[kb] = MFMA16(A, qf[ks], st[kb]); } }
            float cmax = -3.0e38f;
            int qv = qq; asm volatile("" : "+v"(qv));
#pragma unroll
            for (int kb = 0; kb < 8; ++kb)
#pragma unroll
                for (int j = 0; j < 4; ++j) { const int kk = kb * 16 + 4 * g + j; float s = st[kb][j] * 0.125f;
                    if (mode == 0 && kk < qv) s = -1e30f;
                    if (mode == 2 && kk > qv) s = -1e30f;
                    st[kb][j] = s; cmax = fmaxf(cmax, s); }
            cmax = fmaxf(cmax, __shfl_xor(cmax, 16)); cmax = fmaxf(cmax, __shfl_xor(cmax, 32));
            const float mnew = fmaxf(mrun, cmax), alpha = __expf(mrun - mnew);
            mrun = mnew; lsum *= alpha;
#pragma unroll
            for (int i = 0; i < 4; ++i) o[i] = o[i] * alpha;
#pragma unroll
            for (int kb = 0; kb < 8; ++kb)
#pragma unroll
                for (int j = 0; j < 4; ++j) { const float p = __expf(st[kb][j] - mnew); st[kb][j] = p; lsum += p; }
#pragma unroll
            for (int i = 0; i < 4; ++i) {
                const bf16x8 pb = mk8(cvt_pk_bf16(st[2 * i][0], st[2 * i][1]), cvt_pk_bf16(st[2 * i][2], st[2 * i][3]), cvt_pk_bf16(st[2 * i + 1][0], st[2 * i + 1][1]), cvt_pk_bf16(st[2 * i + 1][2], st[2 * i + 1][3]));
#pragma unroll
                for (int dvb = 0; dvb < 4; ++dvb) { const LAS bf16_t* vp = Vt + (dvb * 16 + fr) * AT_VS + i * 32 + 4 * g;
                    const u32x2 lo = *(const LAS u32x2*)vp, hi = *(const LAS u32x2*)(vp + 16);
                    o[dvb] = MFMA16(mk8(lo.x, lo.y, hi.x, hi.y), pb, o[dvb]); }
            }
        }
        lsum += __shfl_xor(lsum, 16); lsum += __shfl_xor(lsum, 32);
        const float inv = 1.f / lsum;
#pragma unroll
        for (int dvb = 0; dvb < 4; ++dvb) { u32x2 w; w.x = cvt_pk_bf16(o[dvb][0] * inv, o[dvb][1] * inv); w.y = cvt_pk_bf16(o[dvb][2] * inv, o[dvb][3] * inv);
            *(u32x2*)(AO + (size_t)row * D + h * 64 + dvb * 16 + 4 * g) = w; }
    }
}

constexpr int RC_QD = 0, RC_KI = 17408, RC_KET = 34816, RC_VT = 53248, RC_ST = 71680, RC_SEG = 106496, RC_DEC = 108544;
__device__ __forceinline__ void rec_phase(LAS unsigned char* lds, const bf16_t* QR, const bf16_t* VR, const bf16_t* KF, const bf16_t* KBK, float* LFF, float* LFB,
                                          const float* state_s, float* new_state, float* odummy, int G, int bid, int tid, int lane, int wave) {
    LAS bf16_t* Qd = (LAS bf16_t*)(lds + RC_QD); LAS bf16_t* Ki = (LAS bf16_t*)(lds + RC_KI); LAS bf16_t* KeT = (LAS bf16_t*)(lds + RC_KET);
    LAS bf16_t* Vt = (LAS bf16_t*)(lds + RC_VT); LAS bf16_t* St = (LAS bf16_t*)(lds + RC_ST);
    LAS float* SEG = (LAS float*)(lds + RC_SEG); LAS float* DEC = (LAS float*)(lds + RC_DEC);
    const int fr = lane & 15, g = lane >> 4, cb = wave & 3, vh = wave >> 2;
    const int kcol = tid & 127, seg = tid >> 7;
    int it, step;
    if (G >= 64) { if (bid < 32) { it = bid; step = 1 << 20; } else { it = bid; step = G - 32; } } else { it = bid; step = G; }
    for (; it < 544; it += step) {
        const bool samp = it < 32;
        int b, h, dir, T, rowbase;
        if (samp) { b = it >> 4; h = (it >> 1) & 7; dir = it & 1; T = 1024; rowbase = MP + b * 1024; }
        else { const int p = it - 32; b = p >> 4; h = (p >> 1) & 7; dir = p & 1; T = 256; rowbase = b * 256; }
        float* LFO = dir ? LFB : LFF; const bf16_t* KK = dir ? KBK : KF;
        const int col0 = h * 128;
        f32x4 S[8];
        if (samp) { const float* sp = state_s + (size_t)((b * 2 + dir) * 8 + h) * 16384;
#pragma unroll
            for (int vb = 0; vb < 8; ++vb)
#pragma unroll
                for (int j = 0; j < 4; ++j) S[vb][j] = sp[(wave * 16 + 4 * g + j) * 128 + vb * 16 + fr];
        } else {
#pragma unroll
            for (int vb = 0; vb < 8; ++vb) S[vb] = (f32x4){0.f, 0.f, 0.f, 0.f};
        }
        __syncthreads();
#pragma unroll
        for (int vb = 0; vb < 8; ++vb) { u32x2 w; w.x = cvt_pk_bf16(S[vb][0], S[vb][1]); w.y = cvt_pk_bf16(S[vb][2], S[vb][3]); *(LAS u32x2*)(St + (vb * 16 + fr) * 136 + wave * 16 + 4 * g) = w; }
        const int nchunk = T >> 6;
        for (int n = 0; n < nchunk; ++n) {
            const int s0 = seg * 16;
            const long rstep = dir ? -(long)D : (long)D;
            const size_t base = (size_t)(rowbase + (dir ? T - 1 - (64 * n + s0) : 64 * n + s0)) * D + col0 + kcol;
            float lf[16]; unsigned short qv[16], kv[16], vv[16];
#pragma unroll
            for (int i = 0; i < 16; ++i) lf[i] = LFO[(long)base + rstep * i];
#pragma unroll
            for (int i = 0; i < 16; ++i) { qv[i] = QR[(long)base + rstep * i]; kv[i] = KK[(long)base + rstep * i]; vv[i] = VR[(long)base + rstep * i]; }
#pragma unroll
            for (int i = 1; i < 16; ++i) lf[i] += lf[i - 1];
            SEG[seg * 128 + kcol] = lf[15];
            __syncthreads();
            const float t0 = SEG[kcol], t1 = SEG[128 + kcol], t2 = SEG[256 + kcol], t3 = SEG[384 + kcol];
            const float prefix = (seg > 0 ? t0 : 0.f) + (seg > 1 ? t1 : 0.f) + (seg > 2 ? t2 : 0.f), total = (t0 + t1) + (t2 + t3);
            float ke[16];
#pragma unroll
            for (int i = 0; i < 16; ++i) {
                const float bc = prefix + lf[i], q = bf2f(qv[i]), k = bf2f(kv[i]);
                const float qd = q * __expf(bc), ki = k * __expf(-bc); ke[i] = k * __expf(total - bc);
                const unsigned pk = cvt_pk_bf16(qd, ki);
                Qd[(s0 + i) * 136 + kcol] = (bf16_t)(pk & 0xffffu); Ki[(s0 + i) * 136 + kcol] = (bf16_t)(pk >> 16);
            }
            {
                u32x4 w0, w1;
                w0.x = cvt_pk_bf16(ke[0], ke[1]); w0.y = cvt_pk_bf16(ke[2], ke[3]); w0.z = cvt_pk_bf16(ke[4], ke[5]); w0.w = cvt_pk_bf16(ke[6], ke[7]);
                w1.x = cvt_pk_bf16(ke[8], ke[9]); w1.y = cvt_pk_bf16(ke[10], ke[11]); w1.z = cvt_pk_bf16(ke[12], ke[13]); w1.w = cvt_pk_bf16(ke[14], ke[15]);
                *(LAS u32x4*)(KeT + kcol * 72 + s0) = w0; *(LAS u32x4*)(KeT + kcol * 72 + s0 + 8) = w1;
                u32x4 x0, x1;
                x0.x = (unsigned)vv[0] | ((unsigned)vv[1] << 16); x0.y = (unsigned)vv[2] | ((unsigned)vv[3] << 16); x0.z = (unsigned)vv[4] | ((unsigned)vv[5] << 16); x0.w = (unsigned)vv[6] | ((unsigned)vv[7] << 16);
                x1.x = (unsigned)vv[8] | ((unsigned)vv[9] << 16); x1.y = (unsigned)vv[10] | ((unsigned)vv[11] << 16); x1.z = (unsigned)vv[12] | ((unsigned)vv[13] << 16); x1.w = (unsigned)vv[14] | ((unsigned)vv[15] << 16);
                *(LAS u32x4*)(Vt + kcol * 72 + s0) = x0; *(LAS u32x4*)(Vt + kcol * 72 + s0 + 8) = x1;
            }
            if (seg == 0) DEC[kcol] = __expf(total);
            __syncthreads();
            bf16x8 qd[4];
#pragma unroll
            for (int ks = 0; ks < 4; ++ks) qd[ks] = *(const LAS bf16x8*)(Qd + (cb * 16 + fr) * 136 + ks * 32 + g * 8);
            f32x4 at[4];
            int cv = cb * 16 + fr - 4 * g; asm volatile("" : "+v"(cv));
#pragma unroll
            for (int sb = 0; sb < 4; ++sb) { at[sb] = (f32x4){0.f, 0.f, 0.f, 0.f};
#pragma unroll
                for (int ks = 0; ks < 4; ++ks) { const bf16x8 A = *(const LAS bf16x8*)(Ki + (sb * 16 + fr) * 136 + ks * 32 + g * 8); at[sb] = MFMA16(A, qd[ks], at[sb]); }
#pragma unroll
                for (int j = 0; j < 4; ++j) if (sb * 16 + j > cv) at[sb][j] = 0.f;
            }
            bf16x8 P[2];
#pragma unroll
            for (int x = 0; x < 2; ++x) P[x] = mk8(cvt_pk_bf16(at[2 * x][0], at[2 * x][1]), cvt_pk_bf16(at[2 * x][2], at[2 * x][3]), cvt_pk_bf16(at[2 * x + 1][0], at[2 * x + 1][1]), cvt_pk_bf16(at[2 * x + 1][2], at[2 * x + 1][3]));
            {
                const int c = cb * 16 + fr; const int t = dir ? T - 1 - (64 * n + c) : 64 * n + c;
                float* orow = (odummy ? odummy : LFO) + (size_t)(rowbase + t) * D + col0;
#pragma unroll
                for (int i = 0; i < 4; ++i) { const int vb = vh * 4 + i; f32x4 acc = {0.f, 0.f, 0.f, 0.f};
#pragma unroll
                    for (int x = 0; x < 2; ++x) { const LAS bf16_t* vp = Vt + (vb * 16 + fr) * 72 + x * 32 + 4 * g; const u32x2 lo = *(const LAS u32x2*)vp, hi = *(const LAS u32x2*)(vp + 16);
                        acc = MFMA16(mk8(lo.x, lo.y, hi.x, hi.y), P[x], acc); }
#pragma unroll
                    for (int ks = 0; ks < 4; ++ks) { const bf16x8 A = *(const LAS bf16x8*)(St + (vb * 16 + fr) * 136 + ks * 32 + g * 8); acc = MFMA16(A, qd[ks], acc); }
                    *(f32x4*)(orow + vb * 16 + 4 * g) = acc; }
            }
            {
                bf16x8 kef[2];
#pragma unroll
                for (int x = 0; x < 2; ++x) kef[x] = *(const LAS bf16x8*)(KeT + (wave * 16 + fr) * 72 + x * 32 + g * 8);
                const f32x4 dc = *(const LAS f32x4*)(DEC + wave * 16 + 4 * g);
#pragma unroll
                for (int vb = 0; vb < 8; ++vb) { f32x4 up = {0.f, 0.f, 0.f, 0.f};
#pragma unroll
                    for (int x = 0; x < 2; ++x) { const bf16x8 B = *(const LAS bf16x8*)(Vt + (vb * 16 + fr) * 72 + x * 32 + g * 8); up = MFMA16(kef[x], B, up); }
                    S[vb] = dc * S[vb] + up; }
            }
            __syncthreads();
#pragma unroll
            for (int vb = 0; vb < 8; ++vb) { u32x2 w; w.x = cvt_pk_bf16(S[vb][0], S[vb][1]); w.y = cvt_pk_bf16(S[vb][2], S[vb][3]); *(LAS u32x2*)(St + (vb * 16 + fr) * 136 + wave * 16 + 4 * g) = w; }
        }
        if (!samp) { float* sp = new_state + (size_t)((b * 2 + dir) * 8 + h) * 16384;
#pragma unroll
            for (int vb = 0; vb < 8; ++vb)
#pragma unroll
                for (int j = 0; j < 4; ++j) sp[(wave * 16 + 4 * g + j) * 128 + vb * 16 + fr] = S[vb][j];
        }
    }
}

#define XB_TMO      128
#define XB_XCNT(j)  (256  + 64 * (j))
#define XB_XSUB(j)  (1280 + 64 * (j))
#define XB_XGEN(j)  (2304 + 64 * (j))
#define XB_TOP      3328
#define XB_TOPGEN   3392
#define XCD_BAR_WORDS 3456
#define XB_SPIN_CAP (1u << 18)

__device__ __forceinline__ unsigned xb_ld(unsigned* p)              { return __hip_atomic_load(p, __ATOMIC_RELAXED, __HIP_MEMORY_SCOPE_AGENT); }
__device__ __forceinline__ unsigned xb_add(unsigned* p, unsigned v) { return __hip_atomic_fetch_add(p, v, __ATOMIC_RELAXED, __HIP_MEMORY_SCOPE_AGENT); }
__device__ __forceinline__ unsigned xb_xcc_id() { return (unsigned)__builtin_amdgcn_s_getreg((3 << 11) | 20) & 0xFu; }
#define XB_SPIN(cond, bar) do { unsigned _sp = 0; while (cond) { __builtin_amdgcn_s_sleep(1); \
    if ((++_sp & 255u) == 0u) { if (xb_ld(&(bar)[XB_TMO])) break; if (_sp > XB_SPIN_CAP) { atomicAdd(&(bar)[XB_TMO], 1u); break; } } } } while (0)

struct XcdBarrier {
    unsigned* bar; unsigned x;
    volatile LAS unsigned* st;
};

__device__ __forceinline__ XcdBarrier xcd_barrier_post(unsigned* bar, volatile LAS unsigned* st) {
    XcdBarrier b; b.bar = bar; b.x = xb_xcc_id(); b.st = st;
    if (threadIdx.x == 0) (void)xb_add(&bar[XB_XCNT(b.x)], 1u);
    return b;
}
__device__ __forceinline__ void xcd_barrier_complete(unsigned* bar, unsigned x, unsigned& nloc, unsigned& nx) {
    const unsigned G = gridDim.x * gridDim.y * gridDim.z;
    unsigned sum, cnt, mine, sp = 0u;
    for (;;) {
        sum = 0u; cnt = 0u; mine = 0u;
#pragma unroll
        for (unsigned j = 0; j < 16; ++j) { const unsigned c = xb_ld(&bar[XB_XCNT(j)]); sum += c; cnt += (c > 0u) ? 1u : 0u; mine = (j == x) ? c : mine; }
        if (sum == G) break;
        __builtin_amdgcn_s_sleep(1);
        if ((++sp & 255u) == 0u) { if (xb_ld(&bar[XB_TMO])) break; if (sp > XB_SPIN_CAP) { atomicAdd(&bar[XB_TMO], 1u); break; } }
    }
    nloc = mine > 0u ? mine : 1u; nx = cnt > 0u ? cnt : 1u;
}

__device__ __forceinline__ void xcd_barrier(const XcdBarrier& b) {
    asm volatile("s_waitcnt vmcnt(0)" ::: "memory");
    __syncthreads();
    if (threadIdx.x == 0) {
        unsigned* bar = b.bar;
        __builtin_amdgcn_s_waitcnt(0);
        unsigned nloc = b.st[0], nx = b.st[1];
        if (nloc == 0u) { xcd_barrier_complete(bar, b.x, nloc, nx); b.st[0] = nloc; b.st[1] = nx; }
        const unsigned old = xb_add(&bar[XB_XSUB(b.x)], 1u);
        const unsigned gen = old / nloc;
        if (old + 1u == (gen + 1u) * nloc) {
            __builtin_amdgcn_fence(__ATOMIC_RELEASE, "agent");
            asm volatile("s_waitcnt vmcnt(0)" ::: "memory");
            const unsigned og = xb_add(&bar[XB_TOP], 1u);
            const unsigned tg = og / nx;
            if (og + 1u == (tg + 1u) * nx) xb_add(&bar[XB_TOPGEN], 1u);
            else XB_SPIN(xb_ld(&bar[XB_TOPGEN]) == tg, bar);
            __builtin_amdgcn_fence(__ATOMIC_ACQUIRE, "agent");
            xb_add(&bar[XB_XGEN(b.x)], 1u);
            asm volatile("s_waitcnt vmcnt(0)" ::: "memory");
        } else {
            XB_SPIN(xb_ld(&bar[XB_XGEN(b.x)]) == gen, bar);
            __builtin_amdgcn_fence(__ATOMIC_ACQUIRE, "agent");
            asm volatile("s_waitcnt vmcnt(0)" ::: "memory");
        }
    }
    __syncthreads();
}

struct Args { const float* in[20]; float* out; unsigned char* ws; int ph_lo, ph_hi; };
typedef const __attribute__((address_space(4))) Args* KArgs;
#define KA() ({ KArgs _p = (KArgs)__builtin_amdgcn_kernarg_segment_ptr(); asm volatile("" : "+s"(_p)); _p; })
__global__ void __launch_bounds__(512, 2) fwd_kernel(Args a_unused) {
    extern __shared__ __attribute__((aligned(16))) unsigned char lds_raw[];
    LAS unsigned char* lds = (LAS unsigned char*)lds_raw;
    cg::grid_group grid = cg::this_grid();
    const int G = gridDim.x, bid = blockIdx.x;
    int lo, hi; { KArgs ka = KA(); lo = ka->ph_lo; hi = ka->ph_hi; }
    XcdBarrier xbar;
    { volatile LAS unsigned* MISC = (volatile LAS unsigned*)(lds + LDS_MISC_OFF);
      if (threadIdx.x < 32) MISC[threadIdx.x] = 0u;
      __syncthreads();
      KArgs ka = KA(); xbar = xcd_barrier_post((unsigned*)(ka->ws + WS_BAR), MISC + 8); }
    int ph = 0;
#define PH_BEGIN if (ph >= lo && ph < hi) { KArgs ka = KA(); unsigned char* ws = ka->ws; (void)ws; int tid = threadIdx.x; asm volatile("" : "+v"(tid)); const int lane = tid & 63, wave = __builtin_amdgcn_readfirstlane(tid >> 6); (void)lane; (void)wave;
#define PH_END   if (ph + 1 < hi) { for (int rep_ = 0; rep_ < REP_SYNC; ++rep_) { if (lo < 0) grid.sync(); else xcd_barrier(xbar); }     } } ++ph;

    PH_BEGIN
    {
        LAS float* scr = (LAS float*)(lds + wave * 16384);
        const int gw = bid * 8 + wave, NGW = G * 8;
        constexpr int I_ADA = 1152, I_W1 = 16 * 176, I_W2 = 44 * 32, I_QKV = 16 * 48, I_AO = 16 * 32, I_RI = 16 * 160, I_RO = 16 * 32;
        constexpr int E1 = I_ADA, E2 = E1 + 4 * I_W1, E3 = E2 + 4 * I_W2, E4 = E3 + I_QKV, E5 = E4 + I_AO, E6 = E5 + I_RI, NITEMS = E6 + I_RO;
        for (int rep = 0; rep < REP_P0; ++rep)
        for (int it = gw; it < NITEMS; it += NGW) {
            if (it < E1) { ada_item(ka->in[7], ka->in[6], ka->in[2], (float*)(ws + WS_MODP), it, lane); continue; }
            const float* W; bf16_t* WT; int K, N, item; bool perm = false;
            if (it < E2) { const int r = it - E1, w = r / I_W1; item = r - w * I_W1; W = ka->in[11] + (size_t)w * D * NFF1; WT = (bf16_t*)(ws + WS_W1) + (size_t)w * NFF1 * D; K = D; N = NFF1; perm = true; }
            else if (it < E3) { const int r = it - E2, w = r / I_W2; item = r - w * I_W2; W = ka->in[12] + (size_t)w * FF * D; WT = (bf16_t*)(ws + WS_W2) + (size_t)w * D * FF; K = FF; N = D; }
            else if (it < E4) { item = it - E3; W = ka->in[13]; WT = (bf16_t*)(ws + WS_WQKV); K = D; N = NQKV; }
            else if (it < E5) { item = it - E4; W = ka->in[14]; WT = (bf16_t*)(ws + WS_WAO); K = D; N = D; }
            else if (it < E6) { item = it - E5; W = ka->in[16]; WT = (bf16_t*)(ws + WS_WRI); K = D; N = NREC; }
            else { item = it - E6; W = ka->in[19]; WT = (bf16_t*)(ws + WS_WRO); K = D; N = D; }
            transpose_item(W, K, N, WT, scr, item, lane, perm);
        }
    }
    PH_END
    PH_BEGIN
    {
        const float* b_ada = ka->in[8]; const float* rec_lb = ka->in[17];
        const float* MODP = (const float*)(ws + WS_MODP); float* MOD = (float*)(ws + WS_MOD); float* LB = (float*)(ws + WS_LB);
        const int gt = bid * 512 + tid, NT = G * 512;
        for (int idx = gt; idx < 2 * 3 * NADA; idx += NT) {
            const int l = idx / (3 * NADA), r = idx - l * 3 * NADA, g = r / NADA, n = r - g * NADA;
            float s = b_ada[l * NADA + n];
#pragma unroll
            for (int kc = 0; kc < 16; ++kc) s += MODP[(size_t)((l * 16 + kc) * 3 + g) * NADA + n];
            MOD[idx] = s;
        }
        for (int idx = gt; idx < 2048; idx += NT) { const int dir = idx >> 10, i = idx & 1023; const float l0 = rec_lb[(dir * 2 + 0) * 1024 + i], l1 = rec_lb[(dir * 2 + 1) * 1024 + i]; LB[idx] = frcp(1.f + __expf(l0 - l1)); }
    }
    PH_END
    PH_BEGIN
    rw_phase(G, bid, wave, lane, ka->in[0], ka->in[1], ka->out, (const float*)(ws + WS_OUTF), (const float*)(ws + WS_MOD), ka->in[10], 0.f, false, true, (const float*)(ws + WS_MOD), ka->in[9], true, (bf16_t*)(ws + WS_H));
    PH_END

    for (int l = 0; l < 2; ++l) {
        for (int s = 0; s < 3; ++s) {
            if (s != 1) {
                PH_BEGIN
                { const int f = l * 2 + (s >> 1);
                  pg8::Gemm g{(const bf16_t*)(ws + WS_H), (const bf16_t*)(ws + WS_W1) + (size_t)f * NFF1 * D, MT, NFF1, D}; pg8::StaticOrder S; S.init(MT, NFF1, G, bid); EpiSwiGLU E{(bf16_t*)(ws + WS_ACT)};
                  for (int rep = 0; rep < REP_GEMM; ++rep) pg8::gemm_phase<EpiSwiGLU, pg8::StaticOrder, true, true>(lds, g, S, E); }
                PH_END
            } else if (l == 0) {
                PH_BEGIN
                { pg8::Gemm g{(const bf16_t*)(ws + WS_H), (const bf16_t*)(ws + WS_WQKV), MT, NQKV, D}; pg8::StaticOrder S; S.init(MT, NQKV, G, bid);
                  EpiQKV E{ws, ka->out};
                  for (int rep = 0; rep < REP_GEMM; ++rep) pg8::gemm_phase<EpiQKV, pg8::StaticOrder, true, true>(lds, g, S, E); }
                PH_END
                PH_BEGIN
                for (int rep = 0; rep < REP_MIX; ++rep) attn_phase(lds, (const bf16_t*)(ws + WS_Q), (const bf16_t*)(ws + WS_KB), (const bf16_t*)(ws + WS_VB), ka->in[3], ka->in[4], ka->in[15], (bf16_t*)(ws + WS_AO), G, bid, tid, lane, wave);
                PH_END
            } else {
                PH_BEGIN
                { pg8::Gemm g{(const bf16_t*)(ws + WS_H), (const bf16_t*)(ws + WS_WRI), MT, NREC, D}; pg8::StaticOrder S; S.init(MT, NREC, G, bid);
                  EpiRecIn E{ws};
                  for (int rep = 0; rep < REP_GEMM; ++rep) pg8::gemm_phase<EpiRecIn, pg8::StaticOrder, true, true>(lds, g, S, E); }
                PH_END
                PH_BEGIN
                { float* ns_out = ka->out + (size_t)MT * D + (size_t)2 * MP * 256;
                  for (int rep = 0; rep < REP_MIX; ++rep) rec_phase(lds, (const bf16_t*)(ws + WS_QR), (const bf16_t*)(ws + WS_VR), (const bf16_t*)(ws + WS_KF), (const bf16_t*)(ws + WS_KBK), (float*)(ws + WS_LFF), (float*)(ws + WS_LFB), ka->in[5], ns_out,
                                                                  rep + 1 < REP_MIX ? (float*)(ws + WS_OUTF) : (float*)nullptr, G, bid, tid, lane, wave); }
                PH_END
                PH_BEGIN
                for (int rep = 0; rep < REP_MIX; ++rep) comb_phase(G, bid, wave, lane, (const float*)(ws + WS_LFF), (const float*)(ws + WS_LFB), (const bf16_t*)(ws + WS_GR), ka->in[18], (bf16_t*)(ws + WS_QR));
                PH_END
            }
            PH_BEGIN
            { pg8::StaticOrder S; S.init(MT, D, G, bid); EpiF32 E{(float*)(ws + WS_OUTF)};
              if (s != 1) { pg8::Gemm g{(const bf16_t*)(ws + WS_ACT), (const bf16_t*)(ws + WS_W2) + (size_t)(l * 2 + (s >> 1)) * D * FF, MT, D, FF};
                  for (int rep = 0; rep < REP_GEMM; ++rep) pg8::gemm_phase<EpiF32, pg8::StaticOrder, true, true>(lds, g, S, E); }
              else { pg8::Gemm g{(const bf16_t*)(ws + (l == 0 ? WS_AO : WS_QR)), (const bf16_t*)(ws + (l == 0 ? WS_WAO : WS_WRO)), MT, D, D};
                  for (int rep = 0; rep < REP_GEMM; ++rep) pg8::gemm_phase<EpiF32, pg8::StaticOrder, true, true>(lds, g, S, E); } }
            PH_END
            PH_BEGIN
            {
                const bool last = (l == 1 && s == 2);
                const int nl = last ? 0 : ((s == 2) ? l + 1 : l), ns = (s == 2) ? 0 : s + 1;
                const float* MOD = (const float*)(ws + WS_MOD);
                rw_phase(G, bid, wave, lane, ka->in[0], ka->in[1], ka->out, (const float*)(ws + WS_OUTF), MOD + (size_t)l * 3 * NADA + s * 3 * D, ka->in[10] + (size_t)(l * 3 + s) * D, (s == 1) ? 1.f : 0.5f, true, (l == 0 && s == 0),
                         MOD + (size_t)nl * 3 * NADA + ns * 3 * D, ka->in[9] + (size_t)(nl * 3 + ns) * D, !last, (bf16_t*)(ws + WS_H));
            }
            PH_END
        }
    }
#undef PH_BEGIN
#undef PH_END
}

extern "C" void kernel_launch(void* const* d_in, const int* in_sizes, int n_in, void* d_out, int out_size, void* d_ws, size_t ws_size, hipStream_t stream) {
    static int grid = 0;
    if (grid == 0) {
        int dev = 0, cus = 0, per_cu = 0;
        if (n_in != 20 || ws_size < WS_END) { fprintf(stderr, "kernel_launch: unexpected n_in %d / ws_size %zu (need %zu)\n", n_in, ws_size, (size_t)WS_END); grid = -1; return; }
        if (hipGetDevice(&dev) != hipSuccess || hipDeviceGetAttribute(&cus, hipDeviceAttributeMultiprocessorCount, dev) != hipSuccess) { grid = -1; return; }
        if (hipFuncSetAttribute((const void*)fwd_kernel, hipFuncAttributeMaxDynamicSharedMemorySize, LDS_BYTES) != hipSuccess) { fprintf(stderr, "kernel_launch: hipFuncSetAttribute failed\n"); grid = -1; return; }
        if (hipOccupancyMaxActiveBlocksPerMultiprocessor(&per_cu, (const void*)fwd_kernel, 512, LDS_BYTES) != hipSuccess || per_cu < 1) { fprintf(stderr, "kernel_launch: occupancy query gave %d\n", per_cu); per_cu = 1; }
        (void)hipGetLastError();
        grid = cus * per_cu;
    }
    if (grid < 0) return;
    if (hipMemsetAsync((char*)d_ws + WS_BAR, 0, WS_BAR_BYTES, stream) != hipSuccess) { fprintf(stderr, "kernel_launch: hipMemsetAsync failed\n"); return; }
    Args a{};
    for (int i = 0; i < 20; ++i) a.in[i] = (const float*)d_in[i];
    a.out = (float*)d_out; a.ws = (unsigned char*)d_ws;
#if MK_MULTI
    for (int p = 0; p < NPHASES; ++p) { a.ph_lo = p; a.ph_hi = p + 1; void* args[] = {&a};
        hipError_t e = hipLaunchCooperativeKernel((const void*)fwd_kernel, dim3(grid), dim3(512), args, LDS_BYTES, stream);
        if (e != hipSuccess) { fprintf(stderr, "launch %d failed: %s\n", p, hipGetErrorString(e)); break; } }
#else
    a.ph_lo = 0; a.ph_hi = NPHASES; void* args[] = {&a};
    hipError_t e = hipLaunchCooperativeKernel((const void*)fwd_kernel, dim3(grid), dim3(512), args, LDS_BYTES, stream);
    if (e != hipSuccess) fprintf(stderr, "cooperative launch failed: %s (grid %d)\n", hipGetErrorString(e), grid);
#endif
}
```
